# Optimizing an MI355X kernel written in HIP

```python
import jax, jax.numpy as jnp
from jax import lax
import numpy as np

D_MODEL = 1024
BATCH = 8
SEQ = 2048
DEPTH = 2

BRANCH_W = D_MODEL // 2
N_BRANCH = 3
N_FOURIER_GROUPS = 4
FOURIER_GW = BRANCH_W // N_FOURIER_GROUPS
CONF_K = 31
SHORT_K = 3
EPS = 1e-6

SPLIT_SIZES = (
    BRANCH_W, BRANCH_W,
    BRANCH_W, BRANCH_W, BRANCH_W,
    BRANCH_W, BRANCH_W, BRANCH_W, BRANCH_W,
    N_BRANCH * D_MODEL,
)
IN_W = sum(SPLIT_SIZES)
SPLIT_IDX = tuple(int(v) for v in np.cumsum(SPLIT_SIZES)[:-1])

kernel_name = "hybrid_fourier_conformer_shortconv_encoder"


def rms_norm(x, g):
    xf = x.astype(jnp.float32)
    y = xf * lax.rsqrt(jnp.mean(xf * xf, axis=-1, keepdims=True) + EPS)
    return (y * g.astype(jnp.float32)).astype(x.dtype)


def layer_norm(x, g, b):
    xf = x.astype(jnp.float32)
    mu = jnp.mean(xf, axis=-1, keepdims=True)
    var = jnp.mean(jnp.square(xf - mu), axis=-1, keepdims=True)
    y = (xf - mu) * lax.rsqrt(var + EPS)
    return (y * g.astype(jnp.float32) + b.astype(jnp.float32)).astype(x.dtype)


def depthwise_conv(u, w, b):
    k, c = w.shape
    pad = (k - 1) // 2
    out = lax.conv_general_dilated(
        u, w[:, None, :].astype(u.dtype), window_strides=(1,), padding=[(pad, pad)],
        dimension_numbers=("NWC", "WIO", "NWC"), feature_group_count=c)
    return out + b


def fourier_mix(u):
    bsz, s, w = u.shape
    ug = u.reshape(bsz, s, N_FOURIER_GROUPS, FOURIER_GW).astype(jnp.float32)
    f = jnp.fft.fftn(ug, axes=(1, 3), norm="ortho").real
    return f.reshape(bsz, s, w).astype(u.dtype)


def setup_inputs(seed: int = 0) -> dict:
    key = jax.random.key(seed)
    ks = jax.random.split(key, 16)
    f32 = jnp.float32
    x = jax.random.normal(ks[0], (BATCH, SEQ, D_MODEL), f32)
    norm_g = 1.0 + 0.05 * jax.random.normal(ks[1], (DEPTH, D_MODEL), f32)
    w_in = jax.random.normal(ks[2], (DEPTH, D_MODEL, IN_W), f32) * D_MODEL ** -0.5
    b_in = 0.01 * jax.random.normal(ks[3], (DEPTH, IN_W), f32)
    conv_c_w = jax.random.normal(ks[4], (DEPTH, CONF_K, BRANCH_W), f32) * CONF_K ** -0.5
    conv_c_b = 0.01 * jax.random.normal(ks[5], (DEPTH, BRANCH_W), f32)
    ln_c_g = 1.0 + 0.05 * jax.random.normal(ks[6], (DEPTH, BRANCH_W), f32)
    ln_c_b = 0.01 * jax.random.normal(ks[7], (DEPTH, BRANCH_W), f32)
    conv_s_w = jax.random.normal(ks[8], (DEPTH, SHORT_K, BRANCH_W), f32) * SHORT_K ** -0.5
    conv_s_b = 0.01 * jax.random.normal(ks[9], (DEPTH, BRANCH_W), f32)
    w_branch = jax.random.normal(ks[10], (DEPTH, N_BRANCH, BRANCH_W, D_MODEL), f32) * BRANCH_W ** -0.5
    w_out = jax.random.normal(ks[11], (DEPTH, D_MODEL, D_MODEL), f32) * D_MODEL ** -0.5
    final_g = 1.0 + 0.05 * jax.random.normal(ks[12], (D_MODEL,), f32)
    return {"x": x, "norm_g": norm_g, "w_in": w_in, "b_in": b_in,
            "conv_c_w": conv_c_w, "conv_c_b": conv_c_b, "ln_c_g": ln_c_g, "ln_c_b": ln_c_b,
            "conv_s_w": conv_s_w, "conv_s_b": conv_s_b, "w_branch": w_branch,
            "w_out": w_out, "final_g": final_g}


def hybrid_layer(x, norm_g, w_in, b_in, conv_c_w, conv_c_b, ln_c_g, ln_c_b,
                 conv_s_w, conv_s_b, w_branch, w_out):
    bsz, s, d = x.shape
    h = rms_norm(x, norm_g)
    p = jnp.einsum("bsd,de->bse", h, w_in) + b_in
    (f_x, f_z, c_a, c_b, c_z, s_bg, s_cg, s_h, s_z, gates) = jnp.split(p, SPLIT_IDX, axis=-1)

    y_f = fourier_mix(f_x) * jax.nn.silu(f_z)

    c = c_a * jax.nn.sigmoid(c_b)
    c = depthwise_conv(c, conv_c_w, conv_c_b)
    c = jax.nn.silu(layer_norm(c, ln_c_g, ln_c_b))
    y_c = c * jax.nn.silu(c_z)

    sc = s_bg * depthwise_conv(s_cg * s_h, conv_s_w, conv_s_b)
    y_s = sc * jax.nn.silu(s_z)

    y = jnp.stack([y_f, y_c, y_s], axis=2)
    yb = jnp.einsum("bskw,kwd->bskd", y, w_branch)
    g = jax.nn.sigmoid(gates.reshape(bsz, s, N_BRANCH, d))
    m = jnp.sum(g * yb, axis=2)
    return x + jnp.einsum("bsd,de->bse", m, w_out)


def reference(x, norm_g, w_in, b_in, conv_c_w, conv_c_b, ln_c_g, ln_c_b,
              conv_s_w, conv_s_b, w_branch, w_out, final_g):
    for l in range(DEPTH):
        x = hybrid_layer(x, norm_g[l], w_in[l], b_in[l], conv_c_w[l], conv_c_b[l],
                         ln_c_g[l], ln_c_b[l], conv_s_w[l], conv_s_b[l],
                         w_branch[l], w_out[l])
    return rms_norm(x, final_g)
```

```cpp
#include <hip/hip_runtime.h>
#include <cstdint>
#include <cstdio>

#ifndef MK_N_LAUNCHES
#define MK_N_LAUNCHES 1
#endif

namespace {
#define LAS __attribute__((address_space(3)))
#ifndef USE_BF16
#define USE_BF16 1
#endif
#if USE_BF16
typedef __bf16 h16;
typedef __bf16 h16x8 __attribute__((ext_vector_type(8)));
typedef __bf16 h16x2 __attribute__((ext_vector_type(2)));
#define MFMA16(a, b, c) __builtin_amdgcn_mfma_f32_16x16x32_bf16(a, b, c, 0, 0, 0)
#else
typedef _Float16 h16;
typedef _Float16 h16x8 __attribute__((ext_vector_type(8)));
typedef _Float16 h16x2 __attribute__((ext_vector_type(2)));
#define MFMA16(a, b, c) __builtin_amdgcn_mfma_f32_16x16x32_f16(a, b, c, 0, 0, 0)
#endif
typedef float f32x4 __attribute__((ext_vector_type(4)));
typedef float f32x2 __attribute__((ext_vector_type(2)));
typedef unsigned u32x4 __attribute__((ext_vector_type(4)));
typedef unsigned u32x2 __attribute__((ext_vector_type(2)));

constexpr int D = 1024, NB = 8, S = 2048, T = NB * S, DEPTH = 2, BW = 512, INW = 7680, CK = 31;
constexpr float EPS = 1e-6f;
constexpr int NP = 8192;
constexpr int NTHREADS = 512, NWAVES = 8;

constexpr size_t MiB = 1u << 20;
constexpr size_t WS_CTL = 0, CTL_BYTES = 1 * MiB;
constexpr size_t CTL_BAR = 16384;
constexpr size_t CTL_SS = 128 * 1024;
constexpr size_t CTL_DUMMY = 64 * 1024;
constexpr size_t CTL_BIAS = 512 * 1024;
constexpr size_t CTL_XS = 576 * 1024;
constexpr size_t CTL_XCNT = 832 * 1024;
constexpr size_t CTL_GBAR = 320 * 1024;
constexpr size_t CTL_PREP = 448 * 1024;
constexpr size_t WS_WB = 1 * MiB;
constexpr size_t WS_WO = 7 * MiB;
constexpr size_t WS_WI = 11 * MiB;
constexpr size_t WS_XB = 43 * MiB;
constexpr size_t WS_Y = 75 * MiB;
constexpr size_t WS_REG = 123 * MiB, REG_B = 16 * MiB;
constexpr size_t REG_PA = 4 * MiB, PA_STEP = 2 * MiB, REG_M = 12 * MiB;
__device__ __forceinline__ unsigned gs_native(int pm, int pn, int k, int rl0, int cl0) {
    return (unsigned)((((pm & 7) * 4 + pn) * 3 + k) * 131072 + ((rl0 >> 6) * 4 + (cl0 >> 5)) * 1024 + (((cl0 >> 3) & 3) * 16 + (rl0 & 15)) * 16);
}
constexpr size_t WS_TAB = 251 * MiB;
constexpr size_t WS_END = 252 * MiB;

constexpr int LDS_BYTES = 163840;
constexpr int MISC_OFF = 163840 - 256;
constexpr int CONV_ROWS = 95, CONV_TILE_BYTES = CONV_ROWS * 1024, CONV_O_OFF = CONV_TILE_BYTES, CONV_O_BYTES = 64 * 1024;
static_assert(CONV_O_OFF + CONV_O_BYTES <= MISC_OFF, "lds map");
constexpr int EPI_SS_OFF = 139264, EPI_BIAS_OFF = EPI_SS_OFF + 1024;

__device__ __forceinline__ unsigned pkh(float a, float b) { h16x2 h = __builtin_convertvector((f32x2){a, b}, h16x2); return __builtin_bit_cast(unsigned, h); }
__device__ __forceinline__ f32x2 unpkh(unsigned u) { h16x2 h = __builtin_bit_cast(h16x2, u); return __builtin_convertvector(h, f32x2); }
__device__ __forceinline__ float sigmoid_f(float x) { return __builtin_amdgcn_rcpf(1.f + __expf(-x)); }
__device__ __forceinline__ f32x4 sigden4(f32x4 v) {
    const f32x4 t = v * -1.4426950408889634f;
    f32x4 e; e[0] = __builtin_amdgcn_exp2f(t[0]); e[1] = __builtin_amdgcn_exp2f(t[1]); e[2] = __builtin_amdgcn_exp2f(t[2]); e[3] = __builtin_amdgcn_exp2f(t[3]);
    return __builtin_elementwise_min(e + 1.0f, (f32x4){16129.f, 16129.f, 16129.f, 16129.f});
}
__device__ __forceinline__ f32x4 sigmoid4(f32x4 v) {
    const f32x4 t = v * -1.4426950408889634f;
    f32x4 e; e[0] = __builtin_amdgcn_exp2f(t[0]); e[1] = __builtin_amdgcn_exp2f(t[1]); e[2] = __builtin_amdgcn_exp2f(t[2]); e[3] = __builtin_amdgcn_exp2f(t[3]);
    const f32x4 d = e + 1.0f;
    f32x4 r; r[0] = __builtin_amdgcn_rcpf(d[0]); r[1] = __builtin_amdgcn_rcpf(d[1]); r[2] = __builtin_amdgcn_rcpf(d[2]); r[3] = __builtin_amdgcn_rcpf(d[3]);
    return r;
}
__device__ __forceinline__ f32x4 silu2den_rcp(f32x4 a, f32x4 b) {
    const f32x4 ta = a * -1.4426950408889634f, tb = b * -1.4426950408889634f;
    f32x4 ea, eb;
    ea[0] = __builtin_amdgcn_exp2f(ta[0]); ea[1] = __builtin_amdgcn_exp2f(ta[1]); ea[2] = __builtin_amdgcn_exp2f(ta[2]); ea[3] = __builtin_amdgcn_exp2f(ta[3]);
    eb[0] = __builtin_amdgcn_exp2f(tb[0]); eb[1] = __builtin_amdgcn_exp2f(tb[1]); eb[2] = __builtin_amdgcn_exp2f(tb[2]); eb[3] = __builtin_amdgcn_exp2f(tb[3]);
    const f32x4 d = (ea + 1.0f) * (eb + 1.0f);
    f32x4 r; r[0] = __builtin_amdgcn_rcpf(d[0]); r[1] = __builtin_amdgcn_rcpf(d[1]); r[2] = __builtin_amdgcn_rcpf(d[2]); r[3] = __builtin_amdgcn_rcpf(d[3]);
    return r;
}
__device__ __forceinline__ float dpp_add(float v, const int ctrl_is  ) {
    const int x = __builtin_bit_cast(int, v);
    int y;
    if (ctrl_is == 0) y = __builtin_amdgcn_update_dpp(x, x, 0xB1, 0xF, 0xF, false);
    else if (ctrl_is == 1) y = __builtin_amdgcn_update_dpp(x, x, 0x4E, 0xF, 0xF, false);
    else if (ctrl_is == 2) y = __builtin_amdgcn_update_dpp(x, x, 0x141, 0xF, 0xF, false);
    else y = __builtin_amdgcn_update_dpp(x, x, 0x140, 0xF, 0xF, false);
    return v + __builtin_bit_cast(float, y);
}
__device__ __forceinline__ float wave_sum_dpp(float v) {
    v = dpp_add(v, 0); v = dpp_add(v, 1); v = dpp_add(v, 2); v = dpp_add(v, 3);
    v += __shfl_xor(v, 16); v += __shfl_xor(v, 32);
    return v;
}
__device__ __forceinline__ float wave_sum(float v) {
#pragma unroll
    for (int o = 1; o < 64; o <<= 1) v += __shfl_xor(v, o);
    return v;
}
#define LDS_WAIT() asm volatile("s_waitcnt lgkmcnt(0)" ::: "memory")
__device__ __forceinline__ void st16_wt(void* base, unsigned byte_off, u32x4 v) {
    __builtin_amdgcn_raw_buffer_store_b128(v, __builtin_amdgcn_make_buffer_rsrc(base, 0, 0x7fffffff, 0x00020000), byte_off, 0, 16);
}
__device__ __forceinline__ void st8_wt(void* base, unsigned byte_off, u32x2 v) {
    __builtin_amdgcn_raw_buffer_store_b64(v, __builtin_amdgcn_make_buffer_rsrc(base, 0, 0x7fffffff, 0x00020000), byte_off, 0, 16);
}
__device__ __forceinline__ unsigned char* opq(unsigned char* p) { asm volatile("" : "+s"(p)); return p; }
__device__ __forceinline__ int opq_v(int v) { asm volatile("" : "+v"(v)); return v; }
__device__ __forceinline__ int opq_s(int v) { asm volatile("" : "+s"(v)); return v; }

#define XB_TMO      128
#define XB_XCNT(j)  (256  + 64 * (j))
#define XB_XSUB(j)  (1280 + 64 * (j))
#define XB_XGEN(j)  (2304 + 64 * (j))
#define XB_TOP      3328
#define XB_TOPGEN   3392
#define XCD_BAR_WORDS 3456
#define XB_SPIN_CAP (1u << 18)
__device__ __forceinline__ unsigned xb_ld(unsigned* p)              { return __hip_atomic_load(p, __ATOMIC_RELAXED, __HIP_MEMORY_SCOPE_AGENT); }
__device__ __forceinline__ unsigned xb_add(unsigned* p, unsigned v) { return __hip_atomic_fetch_add(p, v, __ATOMIC_RELAXED, __HIP_MEMORY_SCOPE_AGENT); }
__device__ __forceinline__ unsigned xb_xcc_id() { return (unsigned)__builtin_amdgcn_s_getreg((3 << 11) | 20) & 0xFu; }
#define XB_SPIN(cond, bar) do { unsigned _sp = 0; while (cond) { __builtin_amdgcn_s_sleep(1); \
    if ((++_sp & 255u) == 0u) { if (xb_ld(&(bar)[XB_TMO])) break; if (_sp > XB_SPIN_CAP) { atomicAdd(&(bar)[XB_TMO], 1u); break; } } } } while (0)
struct XcdBarrier { unsigned* bar; unsigned x; volatile LAS unsigned* st; unsigned G; };
__device__ __forceinline__ XcdBarrier xcd_barrier_post(unsigned* bar, volatile LAS unsigned* st) {
    XcdBarrier b; b.bar = bar; b.x = xb_xcc_id(); b.st = st; b.G = gridDim.x * gridDim.y * gridDim.z;
    if (threadIdx.x == 0) (void)xb_add(&bar[XB_XCNT(b.x)], 1u);
    return b;
}
__device__ __forceinline__ void xcd_barrier_complete(unsigned* bar, unsigned x, unsigned G, unsigned& nloc, unsigned& nx) {
    unsigned sum, cnt, mine, sp = 0u;
    for (;;) {
        sum = 0u; cnt = 0u; mine = 0u;
#pragma unroll
        for (unsigned j = 0; j < 16; ++j) { const unsigned c = xb_ld(&bar[XB_XCNT(j)]); sum += c; cnt += (c > 0u) ? 1u : 0u; mine = (j == x) ? c : mine; }
        if (sum == G) break;
        __builtin_amdgcn_s_sleep(1);
        if ((++sp & 255u) == 0u) { if (xb_ld(&bar[XB_TMO])) break; if (sp > XB_SPIN_CAP) { atomicAdd(&bar[XB_TMO], 1u); break; } }
    }
    nloc = mine > 0u ? mine : 1u; nx = cnt > 0u ? cnt : 1u;
}
__device__ __forceinline__ void xcd_barrier(const XcdBarrier& b, bool local_ok = false) {
    asm volatile("s_waitcnt vmcnt(0)" ::: "memory");
    __syncthreads();
    if (threadIdx.x == 0) {
        unsigned* bar = b.bar;
        __builtin_amdgcn_s_waitcnt(0);
        unsigned nloc = b.st[0], nx = b.st[1];
        if (nloc == 0u) { xcd_barrier_complete(bar, b.x, b.G, nloc, nx); b.st[0] = nloc; b.st[1] = nx; }
        if (local_ok && nx == 1u) {
            asm volatile("buffer_inv sc1" ::: "memory");
            const unsigned old = xb_add(&bar[XB_XSUB(b.x)], 1u);
            const unsigned gen = old / nloc;
            if (old + 1u == (gen + 1u) * nloc) xb_add(&bar[XB_XGEN(b.x)], 1u);
            else XB_SPIN(xb_ld(&bar[XB_XGEN(b.x)]) == gen, bar);
            asm volatile("s_waitcnt vmcnt(0)" ::: "memory");
        } else {
        const unsigned old = xb_add(&bar[XB_XSUB(b.x)], 1u);
        const unsigned gen = old / nloc;
        if (old + 1u == (gen + 1u) * nloc) {
            __builtin_amdgcn_fence(__ATOMIC_RELEASE, "agent");
            asm volatile("s_waitcnt vmcnt(0)" ::: "memory");
            const unsigned og = xb_add(&bar[XB_TOP], 1u);
            const unsigned tg = og / nx;
            if (og + 1u == (tg + 1u) * nx) xb_add(&bar[XB_TOPGEN], 1u);
            else XB_SPIN(xb_ld(&bar[XB_TOPGEN]) == tg, bar);
            __builtin_amdgcn_fence(__ATOMIC_ACQUIRE, "agent");
            xb_add(&bar[XB_XGEN(b.x)], 1u);
            asm volatile("s_waitcnt vmcnt(0)" ::: "memory");
        } else {
            XB_SPIN(xb_ld(&bar[XB_XGEN(b.x)]) == gen, bar);
            __builtin_amdgcn_fence(__ATOMIC_ACQUIRE, "agent");
            asm volatile("s_waitcnt vmcnt(0)" ::: "memory");
        }
        }
    }
    __syncthreads();
}

struct Args {
    const float* x; const float* norm_g; const float* w_in; const float* b_in; const float* conv_c_w; const float* conv_c_b; const float* ln_c_g; const float* ln_c_b;
    const float* conv_s_w; const float* conv_s_b; const float* w_branch; const float* w_out; const float* final_g;
    float* out; unsigned char* ws; int ph_lo, ph_hi;
};
typedef const __attribute__((address_space(4))) Args* KP;
__device__ __forceinline__ KP kargs() { KP p = (KP)__builtin_amdgcn_kernarg_segment_ptr(); asm volatile("" : "+s"(p)); return p; }

constexpr int BM = 256, BK = 64, HALF = 128, HTB = HALF * BK * 2, KSTEP = BK * 2;
__device__ __forceinline__ int lds_byte(int r, int c) { const int st = (r >> 4) * 2 + (c >> 5), rr = r & 15, cc = c & 31, ob = rr * 64 + cc * 2; return st * 1024 + (ob ^ (((ob >> 9) & 1) << 5)); }
__device__ __forceinline__ void stage_rc(int b, int& R, int& C) { const int st = b / 1024, sb = b % 1024, swz = sb ^ (((sb >> 9) & 1) << 5); R = (st >> 1) * 16 + swz / 64; C = (st & 1) * 32 + (swz % 64) / 2; }
__device__ __forceinline__ int perm32(int rho) { const int n = rho >> 4, i = rho & 15; return 8 * (i >> 2) + 4 * n + (i & 3); }

enum Mode { M_ACT = 0, M_GLU, M_MUL, M_MULSILU, M_X, M_GATE, M_YB, M_OUT };
enum Phase { PH_INPROJ = 0, PH_MIX = 2, PH_OUT = 3 };
struct Unit {
    const char* A; const char* B;
    int lda2, ldb2;
    int nt;
    int mode, pm, pn, aux;
    const float* ssp; const float* bip; int ssperm;
    int bperm;
};
#define XB_ARR(l)   (3408 + 16 * (l))
struct Sched {
    int phase, layer, G, c;
    unsigned* arr;
    __device__ __forceinline__ bool next(int i, Unit& u) const {
        const char* w = (const char*)kargs()->ws;
        if (phase == PH_INPROJ) {
            const int L = i * G + c; if (L >= 64 * 20) return false;
            const int xcd = L & 7, off = L >> 3;
            const int tm = 8 * xcd + (off & 7), tn = off >> 3;
            u.nt = 16; u.lda2 = 2048; u.ldb2 = 2048; u.bperm = 0;
            const float* ssl = (const float*)(w + WS_CTL + CTL_SS) + (size_t)layer * T; const float* bil = (const float*)(w + WS_CTL + CTL_BIAS) + (size_t)layer * NP;
            const char* xb = w + WS_XB + (size_t)tm * 256 * 2048;
            const char* wi = w + WS_WI + (size_t)layer * NP * 2048;
            if (tn < 16) {
                u.A = xb; u.B = wi + (size_t)(1024 + 256 * tn) * 2048; u.pm = tm; u.pn = tn;
                u.mode = (tn < 2) ? M_ACT : (tn < 6) ? M_GLU : (tn < 8) ? M_ACT : (tn < 12) ? M_MUL : M_MULSILU;
                u.aux = (tn < 2) ? tn : (tn < 6) ? tn - 2 : (tn < 8) ? tn - 6 : (tn < 12) ? tn - 8 : tn - 12;
                u.ssp = ssl + tm * 256; u.bip = bil + 1024 + 256 * tn; u.ssperm = 0;
            } else {
                u.A = wi + (size_t)(256 * (tn - 16)) * 2048; u.B = w + WS_XB + ((size_t)(tm >> 3) * 2048 + 4 * (tm & 7)) * 2048; u.pm = tn - 16; u.pn = tm; u.mode = M_X; u.aux = 0; u.bperm = 1;
                u.ssp = ssl + (size_t)(tm >> 3) * 2048 + 4 * (tm & 7); u.bip = bil + 256 * (tn - 16); u.ssperm = 1;
            }
            return true;
        } else {
            const int per = (phase == PH_MIX) ? 6 : 1;
            const int tl = c + (i / per) * G, sub = i % per; if (tl >= 256) return false;
            const int xcd = tl & 7, q = tl >> 3;
            u.pm = 8 * xcd + (q >> 2); u.pn = q & 3; u.bperm = 0; u.ssp = nullptr; u.bip = nullptr; u.ssperm = 0;
            if (phase == PH_OUT) {
                u.A = w + WS_REG + (size_t)(u.pm >> 3) * REG_B + REG_M + (size_t)(u.pm & 7) * 256 * 2048; u.B = w + WS_WO + ((size_t)layer * 1024 + 256 * u.pn) * 2048; u.lda2 = 2048; u.ldb2 = 2048; u.nt = 16; u.mode = M_OUT; u.aux = 0;
            } else if (sub < 3) {
                u.A = w + WS_XB + (size_t)u.pm * 256 * 2048; u.B = w + WS_WI + ((size_t)layer * NP + 5120 + 1024 * sub + 256 * u.pn) * 2048; u.lda2 = 2048; u.ldb2 = 2048; u.nt = 16; u.mode = M_GATE; u.aux = sub;
                u.ssp = (const float*)(w + WS_CTL + CTL_SS) + (size_t)layer * T + u.pm * 256; u.bip = (const float*)(w + WS_CTL + CTL_BIAS) + (size_t)layer * NP + 5120 + 1024 * sub + 256 * u.pn;
            } else {
                const int k = sub - 3;
                u.A = w + WS_Y + (size_t)u.pm * 256 * 3072 + k * 1024; u.B = w + WS_WB + (((size_t)layer * 3 + k) * 1024 + 256 * u.pn) * 1024; u.lda2 = 3072; u.ldb2 = 1024; u.nt = 8; u.mode = M_YB; u.aux = k;
            }
            return true;
        }
    }
};

template <int MODE> __device__ __forceinline__ void epi_tok(const f32x4 (&acc)[2][2][4][2], const Unit& u, unsigned char* ws, const LAS float* ssS, const LAS float* biasS, int rl0, int cl0) {
    f32x4 bv[2][2];
#pragma unroll
    for (int bj = 0; bj < 2; ++bj)
#pragma unroll
        for (int n = 0; n < 2; ++n) bv[bj][n] = *(const LAS f32x4*)(biasS + 128 * bj + cl0 + 4 * n);
    h16* dst; int ld, colbase;
    unsigned char* reg = ws + WS_REG + (size_t)(u.pm >> 3) * REG_B;
    if (MODE == M_GATE) { dst = (h16*)reg; ld = 3072; colbase = 1024 * u.aux + 256 * u.pn; }
    else if (MODE == M_ACT) { dst = (h16*)(reg + REG_PA + (u.pn < 2 ? 0 : 2) * PA_STEP); ld = 512; colbase = 256 * u.aux; }
    else { dst = (h16*)(reg + REG_PA + (MODE == M_GLU ? 1 : MODE == M_MUL ? 3 : 4) * PA_STEP); ld = 512; colbase = 128 * u.aux; }
    float rs[2][4];
#pragma unroll
    for (int ai = 0; ai < 2; ++ai)
#pragma unroll
        for (int m = 0; m < 4; ++m) rs[ai][m] = rsqrtf(ssS[128 * ai + 16 * m + rl0] * (1.f / D) + EPS);
#pragma unroll
    for (int ai = 0; ai < 2; ++ai)
#pragma unroll
        for (int m = 0; m < 4; ++m) {
            const int row = (u.pm & 7) * 256 + 128 * ai + 16 * m + rl0;
            const float r1 = rs[ai][m];
            h16* rowp = dst + (size_t)row * ld + colbase + cl0;
            const unsigned rowb = (unsigned)(row * ld + colbase + cl0) * 2u;
            if (MODE == M_ACT || MODE == M_GATE) {
#pragma unroll
                for (int bj = 0; bj < 2; ++bj) {
                    f32x4 v0 = acc[ai][bj][m][0] * r1 + bv[bj][0], v1 = acc[ai][bj][m][1] * r1 + bv[bj][1];
                    if (MODE == M_GATE) { v0 = sigden4(v0); v1 = sigden4(v1); }
                    u32x4 wv; wv.x = pkh(v0[0], v0[1]); wv.y = pkh(v0[2], v0[3]); wv.z = pkh(v1[0], v1[1]); wv.w = pkh(v1[2], v1[3]);
                    if (MODE == M_GATE) *(u32x4*)(reg + gs_native(u.pm, u.pn, u.aux, rl0, cl0) + 8192 * ((ai * 4 + m) * 2 + bj)) = wv;
                    else *(u32x4*)(rowp + 128 * bj) = wv;
                }
            } else {
                f32x4 o[2];
#pragma unroll
                for (int n = 0; n < 2; ++n) {
                    const f32x4 a = acc[ai][0][m][n] * r1 + bv[0][n], b = acc[ai][1][m][n] * r1 + bv[1][n];
                    if (MODE == M_GLU) o[n] = a * sigmoid4(b);
                    else if (MODE == M_MUL) o[n] = a * b;
                    else o[n] = a * b * sigmoid4(b);
                }
                u32x4 wv; wv.x = pkh(o[0][0], o[0][1]); wv.y = pkh(o[0][2], o[0][3]); wv.z = pkh(o[1][0], o[1][1]); wv.w = pkh(o[1][2], o[1][3]);
                *(u32x4*)rowp = wv;
            }
        }
}
__device__ __forceinline__ void epilogue(const f32x4 (&acc)[2][2][4][2], const Unit& u, KP P, LAS unsigned char* lds, int layer, int wr, int wc, int fr, int fq) {
    unsigned char* ws = P->ws;
    const LAS float* ssS = (const LAS float*)(lds + EPI_SS_OFF);
    const LAS float* biasS = (const LAS float*)(lds + EPI_BIAS_OFF);
    const int rl0 = opq_v(wr * 64 + fr);
    const int cl0 = opq_v(wc * 32 + 8 * fq);
    const int mode = u.mode;
    if (mode == M_ACT) { epi_tok<M_ACT>(acc, u, ws, ssS, biasS, rl0, cl0); return; }
    if (mode == M_GATE) { epi_tok<M_GATE>(acc, u, ws, ssS, biasS, rl0, cl0); return; }
    if (mode == M_GLU) { epi_tok<M_GLU>(acc, u, ws, ssS, biasS, rl0, cl0); return; }
    if (mode == M_MUL) { epi_tok<M_MUL>(acc, u, ws, ssS, biasS, rl0, cl0); return; }
    if (mode == M_MULSILU) { epi_tok<M_MULSILU>(acc, u, ws, ssS, biasS, rl0, cl0); return; }
    if (mode == M_X) {
        const int b = u.pn >> 3, pj = u.pn & 7, n10 = 256 * pj;
        f32x4 rc[2][2];
#pragma unroll
        for (int bj = 0; bj < 2; ++bj)
#pragma unroll
            for (int n = 0; n < 2; ++n) {
                const f32x4 s4 = *(const LAS f32x4*)(ssS + 128 * bj + cl0 + 4 * n);
#pragma unroll
                for (int e = 0; e < 4; ++e) rc[bj][n][e] = rsqrtf(s4[e] * (1.f / D) + EPS);
            }
        h16* xt = (h16*)(ws + WS_REG + (size_t)b * REG_B);
#pragma unroll
        for (int ai = 0; ai < 2; ++ai)
#pragma unroll
            for (int m = 0; m < 4; ++m) {
                const int wrow = u.pm * 256 + 128 * ai + 16 * m + rl0;
                const float bvr = biasS[128 * ai + 16 * m + rl0];
                const unsigned rowb = (unsigned)(wrow * 2048 + n10 + cl0) * 2u;
#pragma unroll
                for (int bj = 0; bj < 2; ++bj) {
                    const f32x4 v0 = acc[ai][bj][m][0] * rc[bj][0] + bvr, v1 = acc[ai][bj][m][1] * rc[bj][1] + bvr;
                    u32x4 wv; wv.x = pkh(v0[0], v0[1]); wv.y = pkh(v0[2], v0[3]); wv.z = pkh(v1[0], v1[1]); wv.w = pkh(v1[2], v1[3]);
                    *(u32x4*)((unsigned char*)xt + rowb + 256u * bj) = wv;
                }
                asm volatile("" ::: "memory");
            }
        return;
    }
    if (mode == M_YB) {
        if (u.aux < 2) return;
        unsigned char* reg = ws + WS_REG + (size_t)(u.pm >> 3) * REG_B;
        const unsigned char* g2 = reg + gs_native(u.pm, u.pn, 2, rl0, cl0);
        h16* Mo = (h16*)(reg + REG_M);
#pragma unroll
        for (int ai = 0; ai < 2; ++ai) {
            u32x4 gA[4][2];
#pragma unroll
            for (int m = 0; m < 4; ++m)
#pragma unroll
                for (int bj = 0; bj < 2; ++bj) gA[m][bj] = *(const u32x4*)(g2 + 8192 * ((ai * 4 + m) * 2 + bj));
            __builtin_amdgcn_sched_barrier(0);
#pragma unroll
            for (int m = 0; m < 4; ++m) {
                const size_t row = (size_t)(u.pm & 7) * 256 + 128 * ai + 16 * m + rl0;
                h16* gp = Mo + row * 1024 + 256 * u.pn + cl0;
#pragma unroll
                for (int bj = 0; bj < 2; ++bj) {
                    const u32x4 ga = gA[m][bj];
                    const f32x2 a0 = unpkh(ga.x), a1 = unpkh(ga.y), a2 = unpkh(ga.z), a3 = unpkh(ga.w);
                    const f32x4 v0 = acc[ai][bj][m][0], v1 = acc[ai][bj][m][1];
#define RC(x) __builtin_amdgcn_rcpf(x)
                    u32x4 wv; wv.x = pkh(v0[0] * RC(a0.x), v0[1] * RC(a0.y)); wv.y = pkh(v0[2] * RC(a1.x), v0[3] * RC(a1.y)); wv.z = pkh(v1[0] * RC(a2.x), v1[1] * RC(a2.y)); wv.w = pkh(v1[2] * RC(a3.x), v1[3] * RC(a3.y));
#undef RC
                    *(u32x4*)(gp + 128 * bj) = wv;
                }
                asm volatile("" ::: "memory");
            }
        }
        return;
    }
    {
        h16* xb = (h16*)(ws + WS_XB);
        float* ssn = (float*)(ws + WS_CTL + CTL_SS) + (size_t)(layer + 1) * T;
#pragma unroll
        for (int ai = 0; ai < 2; ++ai) {
            u32x4 rV[4][2];
#pragma unroll
            for (int m = 0; m < 4; ++m)
#pragma unroll
                for (int bj = 0; bj < 2; ++bj) rV[m][bj] = *(const u32x4*)(xb + ((size_t)u.pm * 256 + 128 * ai + 16 * m + rl0) * 1024 + 256 * u.pn + cl0 + 128 * bj);
            __builtin_amdgcn_sched_barrier(0);
#pragma unroll
            for (int m = 0; m < 4; ++m) {
                const size_t row = (size_t)u.pm * 256 + 128 * ai + 16 * m + rl0;
                const size_t off = row * 1024 + 256 * u.pn + cl0;
                float sq = 0.f;
#pragma unroll
                for (int bj = 0; bj < 2; ++bj) {
                    const u32x4 rv = rV[m][bj];
                    const f32x2 a0 = unpkh(rv.x), a1 = unpkh(rv.y), a2 = unpkh(rv.z), a3 = unpkh(rv.w);
                    const f32x4 v0 = (f32x4){a0.x, a0.y, a1.x, a1.y} + acc[ai][bj][m][0], v1 = (f32x4){a2.x, a2.y, a3.x, a3.y} + acc[ai][bj][m][1];
                    u32x4 wv; wv.x = pkh(v0[0], v0[1]); wv.y = pkh(v0[2], v0[3]); wv.z = pkh(v1[0], v1[1]); wv.w = pkh(v1[2], v1[3]);
                    *(u32x4*)(xb + off + 128 * bj) = wv;
                    sq += (v0[0] * v0[0] + v0[1] * v0[1]) + (v0[2] * v0[2] + v0[3] * v0[3]) + (v1[0] * v1[0] + v1[1] * v1[1]) + (v1[2] * v1[2] + v1[3] * v1[3]);
                }
                sq += __shfl_xor(sq, 16); sq += __shfl_xor(sq, 32);
                if (fq == 0) atomicAdd(ssn + row, sq);
                if (m == 3) asm volatile("" ::: "memory");
            }
        }
        return;
    }
}
constexpr int EX_P_OFF = 131072, EX_S_OFF = EX_P_OFF + 4096, EX_FLAG_OFF = EX_S_OFF + 1024;
__device__ __forceinline__ void epi_out_last(f32x4 (&acc)[2][2][4][2], const Unit& u, KP P, LAS unsigned char* lds, int wr, int wc, int fr, int fq) {
    unsigned char* ws = P->ws;
    const int tid = opq_v(threadIdx.x), wid = __builtin_amdgcn_readfirstlane(tid >> 6), lane = tid & 63;
    const int rl0 = opq_v(wr * 64 + fr), cl0 = opq_v(wc * 32 + 8 * fq);
    const h16* xb = (const h16*)(ws + WS_XB);
    LAS float* Pt = (LAS float*)(lds + EX_P_OFF);
    LAS float* St = (LAS float*)(lds + EX_S_OFF);
    volatile LAS unsigned* flag = (volatile LAS unsigned*)(lds + EX_FLAG_OFF);
    float* slots = (float*)(ws + WS_CTL + CTL_XS);
    unsigned* cnt = (unsigned*)(ws + WS_CTL + CTL_XCNT) + 64 * u.pm;
#pragma unroll
    for (int ai = 0; ai < 2; ++ai) {
        u32x4 rV[4][2];
#pragma unroll
        for (int m = 0; m < 4; ++m)
#pragma unroll
            for (int bj = 0; bj < 2; ++bj) rV[m][bj] = *(const u32x4*)(xb + ((size_t)u.pm * 256 + 128 * ai + 16 * m + rl0) * 1024 + 256 * u.pn + cl0 + 128 * bj);
        __builtin_amdgcn_sched_barrier(0);
#pragma unroll
        for (int m = 0; m < 4; ++m) {
            float sq = 0.f;
#pragma unroll
            for (int bj = 0; bj < 2; ++bj) {
                const u32x4 rv = rV[m][bj];
                const f32x2 a0 = unpkh(rv.x), a1 = unpkh(rv.y), a2 = unpkh(rv.z), a3 = unpkh(rv.w);
                f32x4 v0 = acc[ai][bj][m][0], v1 = acc[ai][bj][m][1];
                v0[0] += a0.x; v0[1] += a0.y; v0[2] += a1.x; v0[3] += a1.y; v1[0] += a2.x; v1[1] += a2.y; v1[2] += a3.x; v1[3] += a3.y;
                acc[ai][bj][m][0] = v0; acc[ai][bj][m][1] = v1;
                sq += (v0[0] * v0[0] + v0[1] * v0[1]) + (v0[2] * v0[2] + v0[3] * v0[3]) + (v1[0] * v1[0] + v1[1] * v1[1]) + (v1[2] * v1[2] + v1[3] * v1[3]);
            }
            sq += __shfl_xor(sq, 16); sq += __shfl_xor(sq, 32);
            if (fq == 0) Pt[(128 * ai + 16 * m + rl0) * 4 + wc] = sq;
            asm volatile("" : "+v"(acc[ai][0][m][0]), "+v"(acc[ai][0][m][1]), "+v"(acc[ai][1][m][0]), "+v"(acc[ai][1][m][1]) :: "memory");
        }
    }
    asm volatile("s_waitcnt lgkmcnt(0)" ::: "memory"); __builtin_amdgcn_s_barrier(); asm volatile("" ::: "memory");
    if (tid < 256) {
        const f32x4 p4 = *(const LAS f32x4*)(Pt + tid * 4);
        __hip_atomic_store(slots + ((size_t)u.pm * 4 + u.pn) * 256 + tid, (p4[0] + p4[1]) + (p4[2] + p4[3]), __ATOMIC_RELAXED, __HIP_MEMORY_SCOPE_AGENT);
        asm volatile("s_waitcnt vmcnt(0)" ::: "memory");
        if (lane == 0) __hip_atomic_fetch_add(cnt, 1u, __ATOMIC_RELAXED, __HIP_MEMORY_SCOPE_AGENT);
    }
    if (wid == 0) {
        unsigned sp = 0; bool dead = false;
        while ((unsigned)__builtin_amdgcn_readfirstlane(__hip_atomic_load(cnt, __ATOMIC_RELAXED, __HIP_MEMORY_SCOPE_AGENT)) < 16u) {
            __builtin_amdgcn_s_sleep(2);
            if (++sp > (1u << 20)) { dead = true; break; }
        }
        __builtin_amdgcn_fence(__ATOMIC_ACQUIRE, "agent");
        if (lane == 0) { flag[0] = dead ? 1u : 0u; if (dead) __hip_atomic_store((unsigned*)(ws + WS_CTL + CTL_BAR) + XB_TMO, 1u, __ATOMIC_RELAXED, __HIP_MEMORY_SCOPE_AGENT); }
    }
    asm volatile("s_waitcnt vmcnt(0) lgkmcnt(0)" ::: "memory"); __builtin_amdgcn_s_barrier(); asm volatile("" ::: "memory");
    if (tid < 256) {
        const float* sl = slots + (size_t)u.pm * 4 * 256 + tid;
        float tot = 0.f;
#pragma unroll
        for (int t = 0; t < 4; ++t) tot += __hip_atomic_load(sl + t * 256, __ATOMIC_RELAXED, __HIP_MEMORY_SCOPE_AGENT);
        St[tid] = rsqrtf(tot * (1.f / D) + EPS);
    }
    asm volatile("s_waitcnt lgkmcnt(0)" ::: "memory"); __builtin_amdgcn_s_barrier(); asm volatile("" ::: "memory");
    f32x4 gv[2][2];
#pragma unroll
    for (int bj = 0; bj < 2; ++bj)
#pragma unroll
        for (int n = 0; n < 2; ++n) gv[bj][n] = *(const f32x4*)(P->final_g + 256 * u.pn + 128 * bj + cl0 + 4 * n);
    float* xo = P->out;
#pragma unroll
    for (int ai = 0; ai < 2; ++ai)
#pragma unroll
        for (int m = 0; m < 4; ++m) {
            const int rl = 128 * ai + 16 * m + rl0;
            const float rs = St[rl];
            const size_t off = ((size_t)u.pm * 256 + rl) * 1024 + 256 * u.pn + cl0;
#pragma unroll
            for (int bj = 0; bj < 2; ++bj) { *(f32x4*)(xo + off + 128 * bj) = acc[ai][bj][m][0] * rs * gv[bj][0]; *(f32x4*)(xo + off + 128 * bj + 4) = acc[ai][bj][m][1] * rs * gv[bj][1]; }
        }
}
__device__ __forceinline__ void acc_handover(f32x4 (&acc)[2][2][4][2], const Unit& u, KP P, int wr, int wc, int fr, int fq) {
    unsigned char* ws = P->ws;
    const bool keep = (u.mode == M_YB) && (u.aux < 2);
    {
        int zi = __builtin_amdgcn_readfirstlane(keep ? 0x3f800000 : 0);
        asm volatile("" : "+s"(zi));
        const float z = __builtin_bit_cast(float, zi);
#pragma unroll
        for (int ai = 0; ai < 2; ++ai)
#pragma unroll
            for (int bj = 0; bj < 2; ++bj)
#pragma unroll
                for (int m = 0; m < 4; ++m) { acc[ai][bj][m][0] *= z; acc[ai][bj][m][1] *= z; }
    }
    if (!keep) return;
    const int rl0 = opq_v(wr * 64 + fr), cl0 = opq_v(wc * 32 + 8 * fq);
    const unsigned char* gk = ws + WS_REG + (size_t)(u.pm >> 3) * REG_B + gs_native(u.pm, u.pn, u.aux, rl0, cl0);
#pragma unroll
    for (int ai = 0; ai < 2; ++ai) {
        u32x4 gA[4][2], gB[4][2];
#pragma unroll
        for (int m = 0; m < 4; ++m)
#pragma unroll
            for (int bj = 0; bj < 2; ++bj) { gA[m][bj] = *(const u32x4*)(gk + 8192 * ((ai * 4 + m) * 2 + bj)); gB[m][bj] = *(const u32x4*)(gk + 131072 + 8192 * ((ai * 4 + m) * 2 + bj)); }
        __builtin_amdgcn_sched_barrier(0);
#pragma unroll
        for (int m = 0; m < 4; ++m) {
#pragma unroll
            for (int bj = 0; bj < 2; ++bj) {
                const u32x4 ga = gA[m][bj], gb = gB[m][bj];
                const f32x2 a0 = unpkh(ga.x), a1 = unpkh(ga.y), a2 = unpkh(ga.z), a3 = unpkh(ga.w), b0 = unpkh(gb.x), b1 = unpkh(gb.y), b2 = unpkh(gb.z), b3 = unpkh(gb.w);
                acc[ai][bj][m][0][0] *= b0.x * __builtin_amdgcn_rcpf(a0.x); acc[ai][bj][m][0][1] *= b0.y * __builtin_amdgcn_rcpf(a0.y);
                acc[ai][bj][m][0][2] *= b1.x * __builtin_amdgcn_rcpf(a1.x); acc[ai][bj][m][0][3] *= b1.y * __builtin_amdgcn_rcpf(a1.y);
                acc[ai][bj][m][1][0] *= b2.x * __builtin_amdgcn_rcpf(a2.x); acc[ai][bj][m][1][1] *= b2.y * __builtin_amdgcn_rcpf(a2.y);
                acc[ai][bj][m][1][2] *= b3.x * __builtin_amdgcn_rcpf(a3.x); acc[ai][bj][m][1][3] *= b3.y * __builtin_amdgcn_rcpf(a3.y);
            }
            if (m == 3) asm volatile("" : "+v"(acc[ai][0][0][0]), "+v"(acc[ai][0][0][1]), "+v"(acc[ai][1][0][0]), "+v"(acc[ai][1][0][1]), "+v"(acc[ai][0][1][0]), "+v"(acc[ai][0][1][1]), "+v"(acc[ai][1][1][0]), "+v"(acc[ai][1][1][1]),
                                             "+v"(acc[ai][0][2][0]), "+v"(acc[ai][0][2][1]), "+v"(acc[ai][1][2][0]), "+v"(acc[ai][1][2][1]), "+v"(acc[ai][0][3][0]), "+v"(acc[ai][0][3][1]), "+v"(acc[ai][1][3][0]), "+v"(acc[ai][1][3][1]) :: "memory");
        }
    }
}

__device__ __forceinline__ void gemm_phase(LAS unsigned char* lds, const Sched& Sc, KP P) {
    const int tid = opq_v(threadIdx.x), wid = __builtin_amdgcn_readfirstlane(tid >> 6), lane = tid & 63, wr = wid >> 2, wc = wid & 3, fr = lane & 15, fq = lane >> 4;
    int rA[2], rB[2], rX[2], c2[2];
#pragma unroll
    for (int i = 0; i < 2; ++i) { int R, C; stage_rc(tid * 16 + i * 8192, R, C); rA[i] = R; rB[i] = (R & ~31) + perm32(R & 31); rX[i] = 32 * (rB[i] & 63) + (rB[i] >> 6); c2[i] = C * 2; }
    const unsigned ldsw = (unsigned)wid * 1024u;
    const int aoff = lds_byte(wr * 64 + fr, fq * 8), boff = lds_byte(wc * 32 + fr, fq * 8);
#define G_SA(b, h) (((b) * 2 + (h)) * HTB)
#define G_SB(b, h) ((4 + (b) * 2 + (h)) * HTB)
#define G_STAGE(bufoff, base, ld2, hrow, koff, r0, r1) do { \
        __builtin_amdgcn_global_load_lds((const unsigned*)((base) + (size_t)(unsigned)(((r0) + (hrow)) * (ld2) + c2[0] + (koff))), (LAS unsigned*)(lds + (bufoff) + ldsw), 16, 0, 0); \
        __builtin_amdgcn_global_load_lds((const unsigned*)((base) + (size_t)(unsigned)(((r1) + (hrow)) * (ld2) + c2[1] + (koff))), (LAS unsigned*)(lds + (bufoff) + ldsw + 8192), 16, 0, 0); } while (0)
#define G_STA(bufoff, base, ld2, h, koff) G_STAGE(bufoff, base, ld2, 128 * (h), koff, rA[0], rA[1])
#define G_LDA(dst, b, h) do { _Pragma("unroll") for (int m = 0; m < 4; ++m) _Pragma("unroll") for (int k = 0; k < 2; ++k) dst[m][k] = *(const LAS h16x8*)(lds + G_SA(b, h) + aoff + m * 2048 + k * 1024); } while (0)
#define G_LDB(dst, b, h) do { _Pragma("unroll") for (int n = 0; n < 2; ++n) _Pragma("unroll") for (int k = 0; k < 2; ++k) dst[n][k] = *(const LAS h16x8*)(lds + G_SB(b, h) + boff + n * 2048 + k * 1024); } while (0)
#define G_MMA(ai, bj, At, Bt) do { __builtin_amdgcn_s_setprio(1); _Pragma("unroll") for (int m = 0; m < 4; ++m) _Pragma("unroll") for (int n = 0; n < 2; ++n) _Pragma("unroll") for (int k = 0; k < 2; ++k) \
        acc[ai][bj][m][n] = MFMA16(Bt[n][k], At[m][k], acc[ai][bj][m][n]); __builtin_amdgcn_s_setprio(0); } while (0)
#define G_WAIT_V(n) asm volatile("s_waitcnt vmcnt(" #n ")" ::: "memory")
#define G_WAIT_L(n) asm volatile("s_waitcnt lgkmcnt(" #n ")" ::: "memory")
#define G_BAR __builtin_amdgcn_s_barrier()
#define G_SCHED __builtin_amdgcn_sched_barrier(0)
    Unit cur, nxt; int ui = 0;
    if (!Sc.next(0, cur)) return;
    f32x4 acc[2][2][4][2];
#pragma unroll
    for (int a = 0; a < 2; ++a)
#pragma unroll
        for (int b = 0; b < 2; ++b)
#pragma unroll
            for (int m = 0; m < 4; ++m)
#pragma unroll
                for (int n = 0; n < 2; ++n) acc[a][b][m][n] = (f32x4){0.f, 0.f, 0.f, 0.f};
    h16x8 At[4][2], B0[2][2], B1[2][2];
    { const int q0 = cur.bperm ? rX[0] : rB[0], q1 = cur.bperm ? rX[1] : rB[1], hm = cur.bperm ? 2 : 128;
      G_STAGE(G_SB(0, 0), cur.B, cur.ldb2, 0, 0, q0, q1); G_STAGE(G_SB(0, 1), cur.B, cur.ldb2, hm, 0, q0, q1); G_STA(G_SA(0, 0), cur.A, cur.lda2, 0, 0); G_STA(G_SA(0, 1), cur.A, cur.lda2, 1, 0);
      if (wr == 1) G_BAR;
      G_WAIT_V(2); G_BAR;
      G_STAGE(G_SB(1, 0), cur.B, cur.ldb2, 0, KSTEP, q0, q1); G_STAGE(G_SB(1, 1), cur.B, cur.ldb2, hm, KSTEP, q0, q1);
      G_WAIT_V(6); G_BAR; }
    for (;;) {
        const bool has_next = Sc.next(ui + 1, nxt);
        const char* nA = has_next ? nxt.A : cur.A; const char* nB = has_next ? nxt.B : cur.B;
        const int nlda = has_next ? nxt.lda2 : cur.lda2, nldb = has_next ? nxt.ldb2 : cur.ldb2, nbp = has_next ? nxt.bperm : cur.bperm;
        const int nt = cur.nt;
        for (int t = 0; t < nt; t += 2) {
            const bool last = (t == nt - 2);
            const int k1 = (t + 1) * KSTEP;
            const char* a2 = last ? nA : cur.A; const char* b2 = last ? nB : cur.B;
            const int la2 = last ? nlda : cur.lda2, lb2 = last ? nldb : cur.ldb2;
            const int k2 = last ? 0 : (t + 2) * KSTEP, k3 = k2 + KSTEP;
            const int bp2 = last ? nbp : cur.bperm;
            const int q0 = bp2 ? rX[0] : rB[0], q1 = bp2 ? rX[1] : rB[1], hm = bp2 ? 2 : 128;
            if (last && cur.ssp) {
                const int j = (wid & 3) * 64 + lane;
                const float* src = (wid < 4) ? cur.ssp + (cur.ssperm ? 32 * (j & 63) + (j >> 6) : j) : cur.bip + j;
                __builtin_amdgcn_global_load_lds((const unsigned*)src, (LAS unsigned*)(lds + (wid < 4 ? EPI_SS_OFF : EPI_BIAS_OFF) + (wid & 3) * 256), 4, 0, 0);
            }
            G_LDB(B0, 0, 0); G_LDB(B1, 0, 1); G_SCHED; G_LDA(At, 0, 0); G_STA(G_SA(1, 0), cur.A, cur.lda2, 0, k1); G_STA(G_SA(1, 1), cur.A, cur.lda2, 1, k1);
            G_WAIT_V(8); G_WAIT_L(0); G_BAR; G_MMA(0, 0, At, B0); G_MMA(0, 1, At, B1); G_BAR; G_SCHED;
            G_LDA(At, 0, 1); G_STAGE(G_SB(0, 0), b2, lb2, 0, k2, q0, q1); G_STAGE(G_SB(0, 1), b2, lb2, hm, k2, q0, q1);
            G_WAIT_V(6); G_WAIT_L(0); G_BAR; G_MMA(1, 0, At, B0); G_MMA(1, 1, At, B1); G_BAR; G_SCHED;
            G_LDB(B0, 1, 0); G_LDB(B1, 1, 1); G_SCHED; G_LDA(At, 1, 0); G_STA(G_SA(0, 0), a2, la2, 0, k2); G_STA(G_SA(0, 1), a2, la2, 1, k2);
            G_WAIT_V(8); G_WAIT_L(0); G_BAR; G_MMA(0, 0, At, B0); G_MMA(0, 1, At, B1); G_BAR; G_SCHED;
            G_LDA(At, 1, 1); G_STAGE(G_SB(1, 0), b2, lb2, 0, k3, q0, q1); G_STAGE(G_SB(1, 1), b2, lb2, hm, k3, q0, q1);
            G_WAIT_V(6); G_WAIT_L(0); G_BAR; G_MMA(1, 0, At, B0); G_MMA(1, 1, At, B1); G_BAR; G_SCHED;
        }
        if (ui == 0 && Sc.arr != nullptr && wid == 0) {
            XB_SPIN(xb_ld(&Sc.arr[XB_ARR(Sc.layer)]) < 32u, Sc.arr);
            asm volatile("buffer_inv sc1" ::: "memory");
        }
        if (wr == 0) G_BAR;
        if (cur.mode == M_OUT && Sc.layer == DEPTH - 1) epi_out_last(acc, cur, P, lds, wr, wc, fr, fq);
        else epilogue(acc, cur, P, lds, Sc.layer, wr, wc, fr, fq);
        if (!has_next) break;
        acc_handover(acc, cur, P, wr, wc, fr, fq);
        cur = nxt; ++ui;
        if (wr == 1) G_BAR;
    }
    G_WAIT_V(0);
    G_BAR;
#undef G_SA
#undef G_SB
#undef G_STAGE
#undef G_STA
#undef G_LDA
#undef G_LDB
#undef G_MMA
#undef G_WAIT_V
#undef G_WAIT_L
#undef G_BAR
#undef G_SCHED
}

struct TItem { const float* W; int Nsrc, k0, c0; h16* dst; int dpitch, r0; const float* gk; };
__device__ __forceinline__ void p0_transpose_load(const TItem& t, float (&tv)[32], float (&gv)[32], int lane) {
#pragma unroll
    for (int i = 0; i < 32; ++i) tv[i] = t.W[(size_t)(t.k0 + 2 * i + (lane >> 5)) * t.Nsrc + t.c0 + (lane & 31)];
#pragma unroll
    for (int i = 0; i < 32; ++i) gv[i] = t.gk ? t.gk[t.k0 + 2 * i + (lane >> 5)] : 1.f;
}
__device__ __forceinline__ void p0_transpose_finish(const TItem& t, float (&tv)[32], const float (&gv)[32], LAS float* scr, int lane) {
    const int k0 = t.k0, r0 = t.r0, dpitch = t.dpitch; h16* dst = t.dst;
#pragma unroll
    for (int i = 0; i < 32; ++i) tv[i] *= gv[i];
#pragma unroll
    for (int i = 0; i < 32; ++i) scr[(2 * i + (lane >> 5)) * 33 + (lane & 31)] = tv[i];
    LDS_WAIT(); asm volatile("" ::: "memory");
    const int c = lane & 7;
#pragma unroll
    for (int j = 0; j < 4; ++j) { const int n = (lane >> 3) + 8 * j; const LAS float* s = scr + (8 * c) * 33 + n;
        u32x4 o; o.x = pkh(s[0 * 33], s[1 * 33]); o.y = pkh(s[2 * 33], s[3 * 33]); o.z = pkh(s[4 * 33], s[5 * 33]); o.w = pkh(s[6 * 33], s[7 * 33]);
        st16_wt(dst, (unsigned)((r0 + n) * dpitch + k0 + 8 * c) * 2u, o); }
    LDS_WAIT(); asm volatile("" ::: "memory");
}
__device__ __forceinline__ int inproj_col(int r) {
    if (r >= 5120) return 4608 + (r - 5120);
    const int j = (r - 1024) >> 8, q = (r - 1024) & 255, hf = q >> 7, i = q & 127;
    if (j < 2) return 512 + 256 * j + q;
    if (j < 6) return (hf ? 1536 : 1024) + 128 * (j - 2) + i;
    if (j < 8) return 2048 + 256 * (j - 6) + q;
    if (j < 12) return (hf ? 3584 : 3072) + 128 * (j - 8) + i;
    return (hf ? 4096 : 2560) + 128 * (j - 12) + i;
}
__device__ __forceinline__ void p0_fold_item(KP P, int item, LAS unsigned char* lds) {
    const int tid = opq_v(threadIdx.x); unsigned char* ws = P->ws;
    const int l = item >> 7, gr = (item >> 5) & 3, kb = item & 31, k0 = kb * 32;
    LAS float* Wt = (LAS float*)lds;
    LAS float* cosT = Wt + 128 * 36; LAS float* sinT = cosT + 128;
    const float* W = P->w_in + (size_t)l * D * INW;
    const float* g = P->norm_g + l * D;
    __syncthreads();
    if (tid < 128) { cosT[tid] = cospif(tid * (1.f / 64.f)); sinT[tid] = sinpif(tid * (1.f / 64.f)); }
#pragma unroll
    for (int j = 0; j < 8; ++j) { const int n2 = tid & 127, kk = (tid >> 7) + 4 * j; Wt[n2 * 36 + kk] = W[(size_t)(k0 + kk) * INW + gr * 128 + n2] * g[k0 + kk]; }
    __syncthreads();
    const int pp = tid & 63, kq = __builtin_amdgcn_readfirstlane(tid >> 6);
    f32x4 ec = {0.f, 0.f, 0.f, 0.f}, es = ec, oc = ec, os = ec;
    float bec = 0.f, bes = 0.f, boc = 0.f, bos = 0.f;
    const float* bin = P->b_in + (size_t)l * INW + gr * 128;
    const bool dob = (kb == 0 && kq == 0);
#pragma unroll 4
    for (int m = 0; m < 64; ++m) {
        const int ie = (pp * 2 * m) & 127, io = (pp * (2 * m + 1)) & 127;
        const float ce = cosT[ie], se = sinT[ie], co = cosT[io], so = sinT[io];
        const f32x4 we = *(const LAS f32x4*)(Wt + (2 * m) * 36 + kq * 4), wo = *(const LAS f32x4*)(Wt + (2 * m + 1) * 36 + kq * 4);
        ec += we * ce; es += we * se; oc += wo * co; os += wo * so;
        if (dob) { const float b0 = bin[2 * m], b1 = bin[2 * m + 1]; bec += b0 * ce; bes += b0 * se; boc += b1 * co; bos += b1 * so; }
    }
    h16* wi = (h16*)(ws + WS_WI) + (size_t)l * NP * 1024;
    const int r0 = 2 * (gr * 128 + pp), r1 = r0 + 128;
    { const f32x4 c0 = ec + oc, s0 = es + os, c1 = ec - oc, s1 = es - os;
      u32x2 o; o.x = pkh(c0[0], c0[1]); o.y = pkh(c0[2], c0[3]); st8_wt(wi, (unsigned)(r0 * 1024 + k0 + kq * 4) * 2u, o);
      o.x = pkh(s0[0], s0[1]); o.y = pkh(s0[2], s0[3]); st8_wt(wi, (unsigned)((r0 + 1) * 1024 + k0 + kq * 4) * 2u, o);
      o.x = pkh(c1[0], c1[1]); o.y = pkh(c1[2], c1[3]); st8_wt(wi, (unsigned)(r1 * 1024 + k0 + kq * 4) * 2u, o);
      o.x = pkh(s1[0], s1[1]); o.y = pkh(s1[2], s1[3]); st8_wt(wi, (unsigned)((r1 + 1) * 1024 + k0 + kq * 4) * 2u, o); }
    if (dob) { float* biasP = (float*)(ws + WS_CTL + CTL_BIAS) + (size_t)l * NP;
        __hip_atomic_store(biasP + r0, bec + boc, __ATOMIC_RELAXED, __HIP_MEMORY_SCOPE_AGENT); __hip_atomic_store(biasP + r0 + 1, bes + bos, __ATOMIC_RELAXED, __HIP_MEMORY_SCOPE_AGENT);
        __hip_atomic_store(biasP + r1, bec - boc, __ATOMIC_RELAXED, __HIP_MEMORY_SCOPE_AGENT); __hip_atomic_store(biasP + r1 + 1, bes - bos, __ATOMIC_RELAXED, __HIP_MEMORY_SCOPE_AGENT); }
}
__device__ __forceinline__ void p0_weights(KP P, LAS unsigned char* lds, int c, int G, int l) {
    const int tid = opq_v(threadIdx.x), lane = tid & 63, wave = __builtin_amdgcn_readfirstlane(tid >> 6); unsigned char* ws = P->ws;
    for (int it = c; it < 128; it += G) p0_fold_item(P, 128 * l + it, lds);
    __syncthreads();
    LAS float* scr = (LAS float*)(lds + wave * 16384);
    const int gw = c * NWAVES + wave, NGW = G * NWAVES;
    constexpr int I_WI = 16 * 224, I_WB = 8 * 32, I_WO = 16 * 32;
    constexpr int NITEMS = I_WI + 3 * I_WB + I_WO;
    const bool bal = (G == 256);
    const int half_w = 128 * NWAVES, first_n = 4 * half_w;
    const int it0 = bal ? (c >= 128 ? gw - half_w : first_n + gw) : gw, its = bal ? half_w : NGW, itend = bal ? (c >= 128 ? first_n : NITEMS) : NITEMS;
    auto item = [&](int it) -> TItem {
        int r = it;
        if (r < I_WI) { const int kb = r / 224, rb = r % 224, r0 = 1024 + 32 * rb;
            return TItem{P->w_in + (size_t)l * D * INW, INW, 64 * kb, inproj_col(r0), (h16*)(ws + WS_WI) + (size_t)l * NP * 1024, 1024, r0, P->norm_g + l * D}; }
        r -= I_WI;
        if (r < 3 * I_WB) { const int lk = 3 * l + r / I_WB; r %= I_WB; const int kb = r / 32, rb = r % 32;
            return TItem{P->w_branch + (size_t)lk * BW * D, D, 64 * kb, 32 * rb, (h16*)(ws + WS_WB) + (size_t)lk * 1024 * 512, 512, 32 * rb, nullptr}; }
        r -= 3 * I_WB;
        const int kb = r / 32, rb = r % 32;
        return TItem{P->w_out + (size_t)l * D * D, D, 64 * kb, 32 * rb, (h16*)(ws + WS_WO) + (size_t)l * 1024 * 1024, 1024, 32 * rb, nullptr};
    };
    if (it0 < itend) {
        TItem cur = item(it0);
        float tv[32], gv[32];
        p0_transpose_load(cur, tv, gv, lane);
        for (int it = it0;;) {
            const int nit = it + its; const bool hn = nit < itend;
            TItem nx = cur; float tv2[32], gv2[32];
            if (hn) { nx = item(nit); p0_transpose_load(nx, tv2, gv2, lane); }
            p0_transpose_finish(cur, tv, gv, scr, lane);
            if (!hn) break;
            cur = nx; it = nit;
#pragma unroll
            for (int i = 0; i < 32; ++i) { tv[i] = tv2[i]; gv[i] = gv2[i]; }
        }
    }
    { float* biasP = (float*)(ws + WS_CTL + CTL_BIAS) + (size_t)l * NP;
      for (int i = c * NTHREADS + tid; i < NP - 1024; i += G * NTHREADS) { const int r = 1024 + i; __hip_atomic_store(biasP + r, P->b_in[(size_t)l * INW + inproj_col(r)], __ATOMIC_RELAXED, __HIP_MEMORY_SCOPE_AGENT); } }
    __syncthreads();
}
__device__ __forceinline__ void fft_build_tables(KP P, LAS unsigned char* lds, int part);
__device__ __forceinline__ void p0_prologue(KP P, LAS unsigned char* lds, int c, int G) {
    p0_weights(P, lds, c, G, 0);
    const int tid = opq_v(threadIdx.x), lane = tid & 63, wave = __builtin_amdgcn_readfirstlane(tid >> 6); unsigned char* ws = P->ws;
    const int gw = c * NWAVES + wave, NGW = G * NWAVES;
    if (c >= G - 32) fft_build_tables(P, lds, c - (G - 32));
    { float* ss1 = (float*)(ws + WS_CTL + CTL_SS) + T; for (int i = c * NTHREADS + tid; i < T; i += G * NTHREADS) ss1[i] = 0.f;
      unsigned* xc = (unsigned*)(ws + WS_CTL + CTL_XCNT); for (int i = c * NTHREADS + tid; i < 4096; i += G * NTHREADS) xc[i] = 0u;
      if (c == 1 && tid < 128) ((unsigned*)(ws + WS_CTL + CTL_DUMMY))[tid] = 0u;
      if (c >= 8 && c < 16) { unsigned* gb = (unsigned*)(ws + WS_CTL + CTL_GBAR) + 4096 * (c - 8); for (int i = tid; i < XCD_BAR_WORDS; i += NTHREADS) gb[i] = 0u; }
      if (c == 16 && tid < 16) ((unsigned*)(ws + WS_CTL + CTL_PREP))[tid] = 0u; }
    if (c == 0 && tid < 128) ((unsigned*)(ws + WS_CTL + CTL_DUMMY + 2048))[tid] = USE_BF16 ? 0x3F803F80u : 0x3C003C00u;
    if (c == 0 && tid == 128) *(float*)(ws + WS_CTL + CTL_DUMMY + 2048 + 512) = 1.0f;
    { float* ss0 = (float*)(ws + WS_CTL + CTL_SS); h16* xb = (h16*)(ws + WS_XB);
      for (int row = gw; row < T; row += 4 * NGW) {
          f32x4 v[4][4]; float s[4];
#pragma unroll
          for (int q = 0; q < 4; ++q) { const int rq = row + q * NGW; const f32x4* xr = (const f32x4*)(P->x + (size_t)(rq < T ? rq : row) * D) + lane;
#pragma unroll
              for (int j = 0; j < 4; ++j) v[q][j] = xr[64 * j]; }
#pragma unroll
          for (int q = 0; q < 4; ++q) { float a = 0.f;
#pragma unroll
              for (int j = 0; j < 4; ++j) a += (v[q][j][0] * v[q][j][0] + v[q][j][1] * v[q][j][1]) + (v[q][j][2] * v[q][j][2] + v[q][j][3] * v[q][j][3]);
              s[q] = wave_sum(a); }
#pragma unroll
          for (int q = 0; q < 4; ++q) { const int rq = row + q * NGW;
              if (rq < T) { if (lane == 0) ss0[rq] = s[q];
                  u32x2* o = (u32x2*)(xb + (size_t)rq * D) + lane;
#pragma unroll
                  for (int j = 0; j < 4; ++j) { u32x2 t; t.x = pkh(v[q][j][0], v[q][j][1]); t.y = pkh(v[q][j][2], v[q][j][3]); o[64 * j] = t; } } }
      } }
}
constexpr int FFT_W1_OFF = 0, FFT_TW_OFF = 32768, FFT_ST_OFF = 49152, FFT_LUT_OFF = FFT_ST_OFF + 65536;
static_assert(FFT_LUT_OFF + 256 <= MISC_OFF, "lds map (fft)");
__device__ __forceinline__ void fft_build_tables(KP P, LAS unsigned char* lds, int part) {
    const int tid = opq_v(threadIdx.x);
    unsigned char* tab = P->ws + WS_TAB;
    if (part == 0 && tid < 64) ((float*)(tab + 49152))[tid] = cospif(tid * (1.f / 32.f));
    {
        const int idx = part * NTHREADS + tid;
        const int frag = idx >> 9, nt = frag >> 2, st = frag & 3, ln = (idx >> 3) & 63, e = idx & 7;
        const int kk = 32 * st + 8 * (ln >> 4) + e, j = 16 * nt + (ln & 15), csi = kk >> 6, n_hi = kk & 63, reim = j >> 6, k_lo = j & 63, a = (k_lo * n_hi) & 63;
        const float c = cospif(a * (1.f / 32.f)), sn = sinpif(a * (1.f / 32.f));
        ((h16*)tab)[idx] = (h16)(reim == 0 ? (csi == 0 ? c : -sn) : (csi == 0 ? -sn : -c));
    }
    if (tid < 64) {
        const int idx = part * 64 + tid; const float x = (float)((idx >> 6) * (idx & 63)) * (1.f / 1024.f);
        ((f32x2*)(tab + 32768))[idx] = (f32x2){cospif(x), sinpif(x)};
    }
}
static_assert(FFT_W1_OFF == 0 && FFT_TW_OFF == 32768, "table image layout");
__device__ __forceinline__ void fft_load_tables(KP P, LAS unsigned char* lds) {
    const int tid = opq_v(threadIdx.x);
    const u32x4* src = (const u32x4*)(P->ws + WS_TAB);
    __syncthreads();
    u32x4 v[6];
#pragma unroll
    for (int i = 0; i < 6; ++i) v[i] = src[tid + i * NTHREADS];
#pragma unroll
    for (int i = 0; i < 6; ++i) *(LAS u32x4*)(lds + (tid + i * NTHREADS) * 16) = v[i];
    if (tid < 16) *(LAS u32x4*)(lds + FFT_LUT_OFF + tid * 16) = src[3072 + tid];
    __syncthreads();
}
__device__ __forceinline__ void fft_unit(KP P, int unit, LAS unsigned char* lds) {
    const int tid = opq_v(threadIdx.x), lane = tid & 63, wave = __builtin_amdgcn_readfirstlane(tid >> 6), fr = lane & 15, fq = lane >> 4;
    unsigned char* ws = P->ws;
    const int b = unit & 7, cblk = unit >> 3;
    const LAS float* lut = (const LAS float*)(lds + FFT_LUT_OFF);
    const LAS f32x2* tw = (const LAS f32x2*)(lds + FFT_TW_OFF);
    h16x8 W3[2][2];
#pragma unroll
    for (int mt3 = 0; mt3 < 2; ++mt3)
#pragma unroll
        for (int st = 0; st < 2; ++st)
#pragma unroll
            for (int e = 0; e < 8; ++e) { const int a = ((16 * mt3 + fr) * (16 * st + 4 * fq + (e & 3))) & 31; W3[mt3][st][e] = (h16)((e >> 2) ? lut[(2 * a - 16) & 63] : lut[2 * a]); }
    f32x4 D3[2][2][4];
#pragma unroll
    for (int chi = 0; chi < 2; ++chi) {
        const h16* xt = (const h16*)(ws + WS_REG + (size_t)b * REG_B) + (size_t)(2 * (16 * cblk + 2 * wave + chi)) * 2048;
        h16x8 A[2][4];
#pragma unroll
        for (int mt = 0; mt < 2; ++mt)
#pragma unroll
            for (int st = 0; st < 4; ++st) A[mt][st] = *(const h16x8*)(xt + (size_t)(st >> 1) * 2048 + (16 * mt + fr) * 64 + 32 * (st & 1) + 8 * fq);
        f32x4 D1[2][8];
#pragma unroll
        for (int nt = 0; nt < 8; ++nt) {
            h16x8 Bf[4];
#pragma unroll
            for (int st = 0; st < 4; ++st) Bf[st] = *(const LAS h16x8*)(lds + FFT_W1_OFF + (nt * 4 + st) * 1024 + lane * 16);
#pragma unroll
            for (int mt = 0; mt < 2; ++mt) {
                f32x4 d = (f32x4){0.f, 0.f, 0.f, 0.f};
#pragma unroll
                for (int st = 0; st < 4; ++st) d = MFMA16(A[mt][st], Bf[st], d);
                D1[mt][nt] = d;
            }
        }
#pragma unroll
        for (int mt3 = 0; mt3 < 2; ++mt3)
#pragma unroll
            for (int ntp = 0; ntp < 4; ++ntp) D3[chi][mt3][ntp] = (f32x4){0.f, 0.f, 0.f, 0.f};
#pragma unroll
        for (int mt = 0; mt < 2; ++mt)
#pragma unroll
            for (int ntp = 0; ntp < 4; ++ntp) {
                float vr[4], vi[4];
#pragma unroll
                for (int jj = 0; jj < 4; ++jj) {
                    const f32x2 t = tw[(16 * mt + 4 * fq + jj) * 64 + 16 * ntp + fr];
                    const float ur = D1[mt][ntp][jj], ui = D1[mt][ntp + 4][jj];
                    vr[jj] = ur * t.x + ui * t.y; vi[jj] = ui * t.x - ur * t.y;
                }
                u32x4 pk; pk.x = pkh(vr[0], vr[1]); pk.y = pkh(vr[2], vr[3]); pk.z = pkh(vi[0], vi[1]); pk.w = pkh(vi[2], vi[3]);
                const h16x8 vf = __builtin_bit_cast(h16x8, pk);
#pragma unroll
                for (int mt3 = 0; mt3 < 2; ++mt3) D3[chi][mt3][ntp] = MFMA16(W3[mt3][mt], vf, D3[chi][mt3][ntp]);
            }
    }
    LAS unsigned* stg = (LAS unsigned*)(lds + FFT_ST_OFF);
#pragma unroll
    for (int mt3 = 0; mt3 < 2; ++mt3)
#pragma unroll
        for (int ntp = 0; ntp < 4; ++ntp)
#pragma unroll
            for (int jj = 0; jj < 4; ++jj) { const int k1 = 16 * ntp + fr + 64 * (16 * mt3 + 4 * fq + jj); stg[k1 * 8 + wave] = pkh(D3[0][mt3][ntp][jj], D3[1][mt3][ntp][jj]); }
    __syncthreads();
    {
        const h16* zf = (const h16*)(ws + WS_REG + (size_t)b * REG_B + REG_PA);
        h16* Y = (h16*)(ws + WS_Y);
        const int hf = tid & 1;
        u32x4 zq[8];
#pragma unroll
        for (int i = 0; i < 8; ++i) zq[i] = *(const u32x4*)(zf + (size_t)((tid >> 1) + 256 * i) * 512 + 16 * cblk + 8 * hf);
#pragma unroll
        for (int i = 0; i < 8; ++i) {
            const int k1 = (tid >> 1) + 256 * i;
            const size_t tok = (size_t)b * S + k1;
            const u32x4 sv = *(const LAS u32x4*)(lds + FFT_ST_OFF + k1 * 32 + hf * 16);
            const u32x4 zv = zq[i];
            const f32x2 s0 = unpkh(sv.x), s1 = unpkh(sv.y), s2 = unpkh(sv.z), s3 = unpkh(sv.w);
            f32x2 z0 = unpkh(zv.x), z1 = unpkh(zv.y), z2 = unpkh(zv.z), z3 = unpkh(zv.w);
            { const f32x4 za = (f32x4){z0.x, z0.y, z1.x, z1.y}, zb = (f32x4){z2.x, z2.y, z3.x, z3.y}; const f32x4 ga = za * sigmoid4(za), gb = zb * sigmoid4(zb);
              z0 = (f32x2){ga[0], ga[1]}; z1 = (f32x2){ga[2], ga[3]}; z2 = (f32x2){gb[0], gb[1]}; z3 = (f32x2){gb[2], gb[3]}; }
            const float k = 1.f / 512.f;
            u32x4 o; o.x = pkh(s0.x * z0.x * k, s0.y * z0.y * k); o.y = pkh(s1.x * z1.x * k, s1.y * z1.y * k); o.z = pkh(s2.x * z2.x * k, s2.y * z2.y * k); o.w = pkh(s3.x * z3.x * k, s3.y * z3.y * k);
            *(u32x4*)(Y + tok * 1536 + 16 * cblk + 8 * hf) = o;
        }
    }
    __syncthreads();
}

__device__ __forceinline__ void conv_unit(KP P, int layer, int unit, LAS unsigned char* lds) {
    const int tid = opq_v(threadIdx.x), lane = tid & 63, wave = __builtin_amdgcn_readfirstlane(tid >> 6); unsigned char* ws = P->ws;
    const int t0 = unit * 64, b = t0 >> 11, s0 = t0 & 2047;
    const h16* cg = (const h16*)(ws + WS_REG + (size_t)b * REG_B + REG_PA + 1 * PA_STEP);
    const h16* zc = (const h16*)(ws + WS_REG + (size_t)b * REG_B + REG_PA + 2 * PA_STEP);
    h16* Y = (h16*)(ws + WS_Y);
    LAS unsigned char* tile = lds;
    LAS h16* O = (LAS h16*)(lds + CONV_O_OFF);
    const int p2 = tid & 255, th = tid >> 8;
    f32x2 w[32];
    {
        const float* cw = P->conv_c_w + (size_t)layer * CK * BW + 2 * p2;
#pragma unroll
        for (int j = 0; j < 31; ++j) w[j] = *(const f32x2*)(cw + j * BW);
        w[31] = (f32x2){0.f, 0.f};
    }
    const f32x2 bias = *(const f32x2*)(P->conv_c_b + layer * BW + 2 * p2);
    __syncthreads();
    {
        u32x4 tv[12];
#pragma unroll
        for (int j = 0; j < 12; ++j) {
            const int q = tid + j * NTHREADS, i = q >> 6, ck = q & 63, sq = s0 - 15 + i;
            tv[j] = (u32x4){0u, 0u, 0u, 0u};
            if (i < 94 && sq >= 0 && sq < S) tv[j] = *(const u32x4*)(cg + (size_t)sq * 512 + ck * 8);
        }
#pragma unroll
        for (int j = 0; j < 12; ++j) { const int q = tid + j * NTHREADS, i = q >> 6, ck = q & 63; if (i < CONV_ROWS) *(LAS u32x4*)(tile + i * 1024 + ck * 16) = tv[j]; }
    }
    u32x4 zr[8];
#pragma unroll
    for (int i = 0; i < 8; ++i) zr[i] = *(const u32x4*)(zc + (size_t)(s0 + 8 * wave + i) * 512 + 8 * lane);
    __syncthreads();
    {
        f32x2 win[32];
        const LAS unsigned* tp = (const LAS unsigned*)tile + (32 * th) * 256 + p2;
#pragma unroll
        for (int j = 0; j < 31; ++j) win[j] = unpkh(tp[j * 256]);
        win[31] = (f32x2){0.f, 0.f};
        LAS unsigned* Op = (LAS unsigned*)O + (32 * th) * 256 + p2;
#pragma unroll
        for (int tt = 0; tt < 32; ++tt) {
            win[(tt + 31) & 31] = unpkh(tp[(tt + 31) * 256]);
            f32x2 o0 = bias, o1 = (f32x2){0.f, 0.f};
#pragma unroll
            for (int j = 0; j < 32; j += 2) { o0 += w[j] * win[(tt + j) & 31]; o1 += w[j + 1] * win[(tt + j + 1) & 31]; }
            o0 += o1;
            Op[tt * 256] = pkh(o0.x, o0.y);
        }
    }
    __syncthreads();
    {
        const float* lg = P->ln_c_g + layer * BW + 8 * lane; const float* lb = P->ln_c_b + layer * BW + 8 * lane;
        float g8[8], b8[8];
#pragma unroll
        for (int e = 0; e < 8; ++e) { g8[e] = lg[e]; b8[e] = lb[e]; }
        float v[8][8], sm[8];
#pragma unroll
        for (int i = 0; i < 8; ++i) {
            const u32x4 ov = *(const LAS u32x4*)(O + (8 * wave + i) * 512 + 8 * lane);
            const f32x2 a0 = unpkh(ov.x), a1 = unpkh(ov.y), a2 = unpkh(ov.z), a3 = unpkh(ov.w);
            v[i][0] = a0.x; v[i][1] = a0.y; v[i][2] = a1.x; v[i][3] = a1.y; v[i][4] = a2.x; v[i][5] = a2.y; v[i][6] = a3.x; v[i][7] = a3.y;
            sm[i] = ((v[i][0] + v[i][1]) + (v[i][2] + v[i][3])) + ((v[i][4] + v[i][5]) + (v[i][6] + v[i][7]));
        }
#pragma unroll
        for (int st = 0; st < 4; ++st)
#pragma unroll
            for (int i = 0; i < 8; ++i) sm[i] = dpp_add(sm[i], st);
#pragma unroll
        for (int o = 16; o < 64; o <<= 1)
#pragma unroll
            for (int i = 0; i < 8; ++i) sm[i] += __shfl_xor(sm[i], o);
#pragma unroll
        for (int i = 0; i < 8; ++i) {
            const float mu = sm[i] * (1.f / BW); float q = 0.f;
#pragma unroll
            for (int e = 0; e < 8; ++e) { v[i][e] -= mu; q += v[i][e] * v[i][e]; }
            sm[i] = q;
        }
#pragma unroll
        for (int st = 0; st < 4; ++st)
#pragma unroll
            for (int i = 0; i < 8; ++i) sm[i] = dpp_add(sm[i], st);
#pragma unroll
        for (int o = 16; o < 64; o <<= 1)
#pragma unroll
            for (int i = 0; i < 8; ++i) sm[i] += __shfl_xor(sm[i], o);
#pragma unroll
        for (int i = 0; i < 8; ++i) {
            const float rstd = rsqrtf(sm[i] * (1.f / BW) + EPS);
            const size_t tok = (size_t)t0 + 8 * wave + i;
            const u32x4 zv = zr[i];
            float z[8]; { const f32x2 a0 = unpkh(zv.x), a1 = unpkh(zv.y), a2 = unpkh(zv.z), a3 = unpkh(zv.w); z[0] = a0.x; z[1] = a0.y; z[2] = a1.x; z[3] = a1.y; z[4] = a2.x; z[5] = a2.y; z[6] = a3.x; z[7] = a3.y; }
            f32x4 l0, l1;
#pragma unroll
            for (int e = 0; e < 4; ++e) { l0[e] = v[i][e] * rstd * g8[e] + b8[e]; l1[e] = v[i][4 + e] * rstd * g8[4 + e] + b8[4 + e]; }
            const f32x4 z0 = (f32x4){z[0], z[1], z[2], z[3]}, z1 = (f32x4){z[4], z[5], z[6], z[7]};
            const f32x4 o0 = (l0 * z0) * silu2den_rcp(l0, z0), o1 = (l1 * z1) * silu2den_rcp(l1, z1);
            u32x4 wv; wv.x = pkh(o0[0], o0[1]); wv.y = pkh(o0[2], o0[3]); wv.z = pkh(o1[0], o1[1]); wv.w = pkh(o1[2], o1[3]);
            *(u32x4*)(Y + tok * 1536 + 512 + 8 * lane) = wv;
        }
    }
    __syncthreads();
}
__device__ __forceinline__ void short_chunk(KP P, int layer, int chunk, int lane_) {
    const int lane = opq_v(lane_); unsigned char* ws = P->ws;
    const int t0 = chunk * 8, s0 = t0 & 2047, b = t0 >> 11;
    const h16* u = (const h16*)(ws + WS_REG + (size_t)b * REG_B + REG_PA + 3 * PA_STEP) + 8 * lane;
    const h16* vv = (const h16*)(ws + WS_REG + (size_t)b * REG_B + REG_PA + 4 * PA_STEP) + 8 * lane;
    h16* Y = (h16*)(ws + WS_Y) + 1024 + 8 * lane;
    u32x4 ur[10], vr[8];
#pragma unroll
    for (int i = 0; i < 10; ++i) { const int sq = s0 - 1 + i; ur[i] = (sq >= 0 && sq < S) ? *(const u32x4*)(u + (size_t)sq * 512) : (u32x4){0u, 0u, 0u, 0u}; }
#pragma unroll
    for (int i = 0; i < 8; ++i) vr[i] = *(const u32x4*)(vv + (size_t)(s0 + i) * 512);
    const float* sw = P->conv_s_w + (size_t)layer * 3 * BW + 8 * lane; const float* sb = P->conv_s_b + layer * BW + 8 * lane;
    float w0[8], w1[8], w2[8], bb[8];
#pragma unroll
    for (int e = 0; e < 8; ++e) { w0[e] = sw[e]; w1[e] = sw[BW + e]; w2[e] = sw[2 * BW + e]; bb[e] = sb[e]; }
#pragma unroll
    for (int i = 0; i < 8; ++i) {
        u32x4 wv;
#pragma unroll
        for (int q = 0; q < 4; ++q) {
            const f32x2 a = unpkh(ur[i][q]), b = unpkh(ur[i + 1][q]), c = unpkh(ur[i + 2][q]), v = unpkh(vr[i][q]);
            wv[q] = pkh(v.x * (w0[2 * q] * a.x + w1[2 * q] * b.x + w2[2 * q] * c.x + bb[2 * q]), v.y * (w0[2 * q + 1] * a.y + w1[2 * q + 1] * b.y + w2[2 * q + 1] * c.y + bb[2 * q + 1]));
        }
        *(u32x4*)(Y + (size_t)(t0 + i) * 1536) = wv;
    }
}
__device__ __forceinline__ void final_norm(KP P, int c, int G) {
    const int tid = opq_v(threadIdx.x), lane = tid & 63, wave = tid >> 6; unsigned char* ws = P->ws;
    const float* ss2 = (const float*)(ws + WS_CTL + CTL_SS) + 2 * (size_t)T;
    f32x4 g[4];
#pragma unroll
    for (int j = 0; j < 4; ++j) g[j] = ((const f32x4*)P->final_g)[lane + 64 * j];
    for (int row = c * NWAVES + wave; row < T; row += G * NWAVES) {
        const float rs = rsqrtf(ss2[row] * (1.f / D) + EPS);
        f32x4* xr = (f32x4*)(P->out + (size_t)row * D) + lane;
#pragma unroll
        for (int j = 0; j < 4; ++j) { f32x4 v = xr[64 * j]; xr[64 * j] = v * rs * g[j]; }
    }
}

__global__ void __launch_bounds__(NTHREADS, 2) mega_fwd(Args Pv) {
    extern __shared__ __attribute__((aligned(16))) unsigned char lds_raw[];
    LAS unsigned char* lds = (LAS unsigned char*)lds_raw;
    volatile LAS unsigned* MISC = (volatile LAS unsigned*)(lds + MISC_OFF);
    const int tid = threadIdx.x, lane = tid & 63, wave = __builtin_amdgcn_readfirstlane(tid >> 6);
    const int Gb = gridDim.x, cb = blockIdx.x;
    if (tid < 64) MISC[tid] = 0u;
    __syncthreads();
    XcdBarrier bar = xcd_barrier_post((unsigned*)(Pv.ws + WS_CTL + CTL_BAR), MISC + 8);
    const int lo = Pv.ph_lo, hi = Pv.ph_hi;
    for (int ph = lo; ph < hi; ++ph) {
#ifdef REP_KIND
        const int nrep = ((ph == 0 && REP_KIND == 4) || (ph >= 1 && ph <= 8 && ((ph - 1) & 3) == REP_KIND)) ? 2 : 1;
#else
        const int nrep = 1;
#endif
        for (int rep = 0; rep < nrep; ++rep) {
        const int G = opq_s(Gb), c = opq_s(cb);
        if (ph == 0) p0_prologue(kargs(), lds, c, G);
        else {
            const int l = (ph - 1) >> 2, k = (ph - 1) & 3;
            if (k == 1) {
                const int rot = __builtin_amdgcn_readfirstlane(((c >> 3) + (c & 7)) % 3);
                for (int step = 0; step < 3; ++step) {
                    int job = step + rot; job = job >= 3 ? job - 3 : job;
                    if (job == 0) { if (c < 256) fft_load_tables(kargs(), lds); for (int u = c; u < 256; u += G) fft_unit(kargs(), u, lds); }
                    else if (job == 1) { for (int u = c; u < T / 64; u += G) conv_unit(kargs(), l, (u & 7) * 32 + (u >> 3), lds); }
                    else { for (int u = c; u < T / 64; u += G) short_chunk(kargs(), l, ((u & 7) * 32 + (u >> 3)) * NWAVES + wave, lane); }
                }
                if (l + 1 < DEPTH) p0_weights(kargs(), lds, c, G, l + 1);
            } else {
                const bool split = (k == 2) && (G == 256) && (MISC[11] == 1u);
                Sched sc{k, l, G, c, split ? (unsigned*)(kargs()->ws + WS_CTL + CTL_GBAR) + 4096 * (c & 7) : nullptr}; gemm_phase(lds, sc, kargs()); }
        }
        if (ph + 1 < hi || rep + 1 < nrep) {
            unsigned* gbar = (unsigned*)(kargs()->ws + WS_CTL + CTL_GBAR) + 4096 * (c & 7);
            unsigned* prep = (unsigned*)(kargs()->ws + WS_CTL + CTL_PREP);
            const bool grp = (G == 256) && ph > 0;
            if (!grp) {
                xcd_barrier(bar);
                if (ph == 0 && G == 256 && tid == 0) (void)xb_add(&gbar[XB_XCNT(bar.x)], 1u);
            } else {
                XcdBarrier gb; gb.bar = gbar; gb.x = bar.x; gb.st = MISC + 10; gb.G = 32u;
                if (((ph - 1) & 3) == 1 && MISC[11] == 1u) {
                    asm volatile("s_waitcnt vmcnt(0)" ::: "memory");
                    __syncthreads();
                    if (tid == 0) (void)xb_add(&gbar[XB_ARR((ph - 1) >> 2)], 1u);
                } else xcd_barrier(gb, true);
                if (ph == 2 && tid == 0) (void)xb_add(prep, 1u);
                if (ph == 4) {
                    if (tid == 0) { XB_SPIN(xb_ld(prep) < 256u, gbar); __builtin_amdgcn_fence(__ATOMIC_ACQUIRE, "agent"); }
                    __syncthreads();
                }
            }
        }
        }
    }
}
}

extern "C" void kernel_launch(void* const* d_in, const int* in_sizes, int n_in, void* d_out, int out_size, void* d_ws, size_t ws_size, hipStream_t stream) {
    static int grid = 0;
    if (grid == 0) {
        int dev = 0, cus = 0, per_cu = 0;
        if (n_in != 13 || out_size != T * D || ws_size < WS_END) { fprintf(stderr, "kernel_launch: unexpected problem shape (n_in %d, out %d, ws %zu)\n", n_in, out_size, ws_size); grid = -1; return; }
        if (hipGetDevice(&dev) != hipSuccess || hipDeviceGetAttribute(&cus, hipDeviceAttributeMultiprocessorCount, dev) != hipSuccess) { grid = -1; return; }
        if (hipFuncSetAttribute((const void*)mega_fwd, hipFuncAttributeMaxDynamicSharedMemorySize, LDS_BYTES) != hipSuccess) { fprintf(stderr, "kernel_launch: hipFuncSetAttribute failed\n"); grid = -1; return; }
        if (hipOccupancyMaxActiveBlocksPerMultiprocessor(&per_cu, (const void*)mega_fwd, NTHREADS, LDS_BYTES) != hipSuccess || per_cu < 1) { fprintf(stderr, "kernel_launch: occupancy query says %d blocks per CU\n", per_cu); per_cu = 1; }
        (void)hipGetLastError();
        grid = cus;
        if (grid > 256) grid = 256;
        grid &= ~7;
    }
    if (grid <= 0) return;
    (void)hipMemsetAsync((char*)d_ws + WS_CTL + CTL_BAR, 0, XCD_BAR_WORDS * 4, stream);
    Args a{};
    a.x = (const float*)d_in[0]; a.norm_g = (const float*)d_in[1]; a.w_in = (const float*)d_in[2]; a.b_in = (const float*)d_in[3]; a.conv_c_w = (const float*)d_in[4]; a.conv_c_b = (const float*)d_in[5];
    a.ln_c_g = (const float*)d_in[6]; a.ln_c_b = (const float*)d_in[7]; a.conv_s_w = (const float*)d_in[8]; a.conv_s_b = (const float*)d_in[9]; a.w_branch = (const float*)d_in[10]; a.w_out = (const float*)d_in[11];
    a.final_g = (const float*)d_in[12]; a.out = (float*)d_out; a.ws = (unsigned char*)d_ws;
#if MK_N_LAUNCHES == 1
    a.ph_lo = 0; a.ph_hi = 9;
    hipLaunchKernelGGL(mega_fwd, dim3(grid), dim3(NTHREADS), LDS_BYTES, stream, a);
#else
    for (int p = 0; p < 9; ++p) { a.ph_lo = p; a.ph_hi = p + 1; hipLaunchKernelGGL(mega_fwd, dim3(grid), dim3(NTHREADS), LDS_BYTES, stream, a); }
#endif
}
```

```cpp
#include <hip/hip_runtime.h>
#include <cstdint>
#include <cstdio>

#ifndef MK_N_LAUNCHES
#define MK_N_LAUNCHES 1
#endif

namespace {
#define LAS __attribute__((address_space(3)))
#ifndef USE_BF16
#define USE_BF16 1
#endif
#if USE_BF16
typedef __bf16 h16;
typedef __bf16 h16x8 __attribute__((ext_vector_type(8)));
typedef __bf16 h16x2 __attribute__((ext_vector_type(2)));
#define MFMA16(a, b, c) __builtin_amdgcn_mfma_f32_16x16x32_bf16(a, b, c, 0, 0, 0)
#else
typedef _Float16 h16;
typedef _Float16 h16x8 __attribute__((ext_vector_type(8)));
typedef _Float16 h16x2 __attribute__((ext_vector_type(2)));
#define MFMA16(a, b, c) __builtin_amdgcn_mfma_f32_16x16x32_f16(a, b, c, 0, 0, 0)
#endif
typedef float f32x4 __attribute__((ext_vector_type(4)));
typedef float f32x2 __attribute__((ext_vector_type(2)));
typedef unsigned u32x4 __attribute__((ext_vector_type(4)));
typedef unsigned u32x2 __attribute__((ext_vector_type(2)));

constexpr int D = 1024, NB = 8, S = 2048, T = NB * S, DEPTH = 2, BW = 512, INW = 7680, CK = 31;
constexpr float EPS = 1e-6f;
constexpr int NP = 8192;
constexpr int NTHREADS = 512, NWAVES = 8;

constexpr size_t MiB = 1u << 20;
constexpr size_t WS_CTL = 0, CTL_BYTES = 1 * MiB;
constexpr size_t CTL_BAR = 16384;
constexpr size_t CTL_SS = 128 * 1024;
constexpr size_t CTL_DUMMY = 64 * 1024;
constexpr size_t CTL_BIAS = 512 * 1024;
constexpr size_t CTL_XS = 576 * 1024;
constexpr size_t CTL_XCNT = 832 * 1024;
constexpr size_t CTL_GBAR = 320 * 1024;
constexpr size_t CTL_PREP = 448 * 1024;
constexpr size_t WS_WB = 1 * MiB;
constexpr size_t WS_WO = 7 * MiB;
constexpr size_t WS_WI = 11 * MiB;
constexpr size_t WS_XB = 43 * MiB;
constexpr size_t WS_Y = 75 * MiB;
constexpr size_t WS_REG = 123 * MiB, REG_B = 16 * MiB;
constexpr size_t REG_PA = 4 * MiB, PA_STEP = 2 * MiB, REG_M = 12 * MiB;
__device__ __forceinline__ unsigned gs_native(int pm, int pn, int k, int rl0, int cl0) {
    return (unsigned)((((pm & 7) * 4 + pn) * 3 + k) * 131072 + ((rl0 >> 6) * 4 + (cl0 >> 5)) * 1024 + (((cl0 >> 3) & 3) * 16 + (rl0 & 15)) * 16);
}
constexpr size_t WS_TAB = 251 * MiB;
constexpr size_t WS_END = 252 * MiB;

constexpr int LDS_BYTES = 163840;
constexpr int MISC_OFF = 163840 - 256;
constexpr int CONV_ROWS = 95, CONV_TILE_BYTES = CONV_ROWS * 1024, CONV_O_OFF = CONV_TILE_BYTES, CONV_O_BYTES = 64 * 1024;
static_assert(CONV_O_OFF + CONV_O_BYTES <= MISC_OFF, "lds map");
constexpr int EPI_SS_OFF = 139264, EPI_BIAS_OFF = EPI_SS_OFF + 1024;

__device__ __forceinline__ unsigned pkh(float a, float b) { h16x2 h = __builtin_convertvector((f32x2){a, b}, h16x2); return __builtin_bit_cast(unsigned, h); }
__device__ __forceinline__ f32x2 unpkh(unsigned u) { h16x2 h = __builtin_bit_cast(h16x2, u); return __builtin_convertvector(h, f32x2); }
__device__ __forceinline__ float sigmoid_f(float x) { return __builtin_amdgcn_rcpf(1.f + __expf(-x)); }
__device__ __forceinline__ f32x4 sigden4(f32x4 v) {
    const f32x4 t = v * -1.4426950408889634f;
    f32x4 e; e[0] = __builtin_amdgcn_exp2f(t[0]); e[1] = __builtin_amdgcn_exp2f(t[1]); e[2] = __builtin_amdgcn_exp2f(t[2]); e[3] = __builtin_amdgcn_exp2f(t[3]);
    return __builtin_elementwise_min(e + 1.0f, (f32x4){16129.f, 16129.f, 16129.f, 16129.f});
}
__device__ __forceinline__ f32x4 sigmoid4(f32x4 v) {
    const f32x4 t = v * -1.4426950408889634f;
    f32x4 e; e[0] = __builtin_amdgcn_exp2f(t[0]); e[1] = __builtin_amdgcn_exp2f(t[1]); e[2] = __builtin_amdgcn_exp2f(t[2]); e[3] = __builtin_amdgcn_exp2f(t[3]);
    const f32x4 d = e + 1.0f;
    f32x4 r; r[0] = __builtin_amdgcn_rcpf(d[0]); r[1] = __builtin_amdgcn_rcpf(d[1]); r[2] = __builtin_amdgcn_rcpf(d[2]); r[3] = __builtin_amdgcn_rcpf(d[3]);
    return r;
}
__device__ __forceinline__ f32x4 silu2den_rcp(f32x4 a, f32x4 b) {
    const f32x4 ta = a * -1.4426950408889634f, tb = b * -1.4426950408889634f;
    f32x4 ea, eb;
    ea[0] = __builtin_amdgcn_exp2f(ta[0]); ea[1] = __builtin_amdgcn_exp2f(ta[1]); ea[2] = __builtin_amdgcn_exp2f(ta[2]); ea[3] = __builtin_amdgcn_exp2f(ta[3]);
    eb[0] = __builtin_amdgcn_exp2f(tb[0]); eb[1] = __builtin_amdgcn_exp2f(tb[1]); eb[2] = __builtin_amdgcn_exp2f(tb[2]); eb[3] = __builtin_amdgcn_exp2f(tb[3]);
    const f32x4 d = (ea + 1.0f) * (eb + 1.0f);
    f32x4 r; r[0] = __builtin_amdgcn_rcpf(d[0]); r[1] = __builtin_amdgcn_rcpf(d[1]); r[2] = __builtin_amdgcn_rcpf(d[2]); r[3] = __builtin_amdgcn_rcpf(d[3]);
    return r;
}
__device__ __forceinline__ float dpp_add(float v, const int ctrl_is  ) {
    const int x = __builtin_bit_cast(int, v);
    int y;
    if (ctrl_is == 0) y = __builtin_amdgcn_update_dpp(x, x, 0xB1, 0xF, 0xF, false);
    else if (ctrl_is == 1) y = __builtin_amdgcn_update_dpp(x, x, 0x4E, 0xF, 0xF, false);
    else if (ctrl_is == 2) y = __builtin_amdgcn_update_dpp(x, x, 0x141, 0xF, 0xF, false);
    else y = __builtin_amdgcn_update_dpp(x, x, 0x140, 0xF, 0xF, false);
    return v + __builtin_bit_cast(float, y);
}
__device__ __forceinline__ float wave_sum_dpp(float v) {
    v = dpp_add(v, 0); v = dpp_add(v, 1); v = dpp_add(v, 2); v = dpp_add(v, 3);
    v += __shfl_xor(v, 16); v += __shfl_xor(v, 32);
    return v;
}
__device__ __forceinline__ float wave_sum(float v) {
#pragma unroll
    for (int o = 1; o < 64; o <<= 1) v += __shfl_xor(v, o);
    return v;
}
#define LDS_WAIT() asm volatile("s_waitcnt lgkmcnt(0)" ::: "memory")
__device__ __forceinline__ void st16_wt(void* base, unsigned byte_off, u32x4 v) {
    __builtin_amdgcn_raw_buffer_store_b128(v, __builtin_amdgcn_make_buffer_rsrc(base, 0, 0x7fffffff, 0x00020000), byte_off, 0, 16);
}
__device__ __forceinline__ void st8_wt(void* base, unsigned byte_off, u32x2 v) {
    __builtin_amdgcn_raw_buffer_store_b64(v, __builtin_amdgcn_make_buffer_rsrc(base, 0, 0x7fffffff, 0x00020000), byte_off, 0, 16);
}
__device__ __forceinline__ unsigned char* opq(unsigned char* p) { asm volatile("" : "+s"(p)); return p; }
__device__ __forceinline__ int opq_v(int v) { asm volatile("" : "+v"(v)); return v; }
__device__ __forceinline__ int opq_s(int v) { asm volatile("" : "+s"(v)); return v; }

#define XB_TMO      128
#define XB_XCNT(j)  (256  + 64 * (j))
#define XB_XSUB(j)  (1280 + 64 * (j))
#define XB_XGEN(j)  (2304 + 64 * (j))
#define XB_TOP      3328
#define XB_TOPGEN   3392
#define XCD_BAR_WORDS 3456
#define XB_SPIN_CAP (1u << 18)
__device__ __forceinline__ unsigned xb_ld(unsigned* p)              { return __hip_atomic_load(p, __ATOMIC_RELAXED, __HIP_MEMORY_SCOPE_AGENT); }
__device__ __forceinline__ unsigned xb_add(unsigned* p, unsigned v) { return __hip_atomic_fetch_add(p, v, __ATOMIC_RELAXED, __HIP_MEMORY_SCOPE_AGENT); }
__device__ __forceinline__ unsigned xb_xcc_id() { return (unsigned)__builtin_amdgcn_s_getreg((3 << 11) | 20) & 0xFu; }
#define XB_SPIN(cond, bar) do { unsigned _sp = 0; while (cond) { __builtin_amdgcn_s_sleep(1); \
    if ((++_sp & 255u) == 0u) { if (xb_ld(&(bar)[XB_TMO])) break; if (_sp > XB_SPIN_CAP) { atomicAdd(&(bar)[XB_TMO], 1u); break; } } } } while (0)
struct XcdBarrier { unsigned* bar; unsigned x; volatile LAS unsigned* st; unsigned G; };
__device__ __forceinline__ XcdBarrier xcd_barrier_post(unsigned* bar, volatile LAS unsigned* st) {
    XcdBarrier b; b.bar = bar; b.x = xb_xcc_id(); b.st = st; b.G = gridDim.x * gridDim.y * gridDim.z;
    if (threadIdx.x == 0) (void)xb_add(&bar[XB_XCNT(b.x)], 1u);
    return b;
}
__device__ __forceinline__ void xcd_barrier_complete(unsigned* bar, unsigned x, unsigned G, unsigned& nloc, unsigned& nx) {
    unsigned sum, cnt, mine, sp = 0u;
    for (;;) {
        sum = 0u; cnt = 0u; mine = 0u;
#pragma unroll
        for (unsigned j = 0; j < 16; ++j) { const unsigned c = xb_ld(&bar[XB_XCNT(j)]); sum += c; cnt += (c > 0u) ? 1u : 0u; mine = (j == x) ? c : mine; }
        if (sum == G) break;
        __builtin_amdgcn_s_sleep(1);
        if ((++sp & 255u) == 0u) { if (xb_ld(&bar[XB_TMO])) break; if (sp > XB_SPIN_CAP) { atomicAdd(&bar[XB_TMO], 1u); break; } }
    }
    nloc = mine > 0u ? mine : 1u; nx = cnt > 0u ? cnt : 1u;
}
__device__ __forceinline__ void xcd_barrier(const XcdBarrier& b, bool local_ok = false) {
    asm volatile("s_waitcnt vmcnt(0)" ::: "memory");
    __syncthreads();
    if (threadIdx.x == 0) {
        unsigned* bar = b.bar;
        __builtin_amdgcn_s_waitcnt(0);
        unsigned nloc = b.st[0], nx = b.st[1];
        if (nloc == 0u) { xcd_barrier_complete(bar, b.x, b.G, nloc, nx); b.st[0] = nloc; b.st[1] = nx; }
        if (local_ok && nx == 1u) {
            asm volatile("buffer_inv sc1" ::: "memory");
            const unsigned old = xb_add(&bar[XB_XSUB(b.x)], 1u);
            const unsigned gen = old / nloc;
            if (old + 1u == (gen + 1u) * nloc) xb_add(&bar[XB_XGEN(b.x)], 1u);
            else XB_SPIN(xb_ld(&bar[XB_XGEN(b.x)]) == gen, bar);
            asm volatile("s_waitcnt vmcnt(0)" ::: "memory");
        } else {
        const unsigned old = xb_add(&bar[XB_XSUB(b.x)], 1u);
        const unsigned gen = old / nloc;
        if (old + 1u == (gen + 1u) * nloc) {
            __builtin_amdgcn_fence(__ATOMIC_RELEASE, "agent");
            asm volatile("s_waitcnt vmcnt(0)" ::: "memory");
            const unsigned og = xb_add(&bar[XB_TOP], 1u);
            const unsigned tg = og / nx;
            if (og + 1u == (tg + 1u) * nx) xb_add(&bar[XB_TOPGEN], 1u);
            else XB_SPIN(xb_ld(&bar[XB_TOPGEN]) == tg, bar);
            __builtin_amdgcn_fence(__ATOMIC_ACQUIRE, "agent");
            xb_add(&bar[XB_XGEN(b.x)], 1u);
            asm volatile("s_waitcnt vmcnt(0)" ::: "memory");
        } else {
            XB_SPIN(xb_ld(&bar[XB_XGEN(b.x)]) == gen, bar);
            __builtin_amdgcn_fence(__ATOMIC_ACQUIRE, "agent");
            asm volatile("s_waitcnt vmcnt(0)" ::: "memory");
        }
        }
    }
    __syncthreads();
}

struct Args {
    const float* x; const float* norm_g; const float* w_in; const float* b_in; const float* conv_c_w; const float* conv_c_b; const float* ln_c_g; const float* ln_c_b;
    const float* conv_s_w; const float* conv_s_b; const float* w_branch; const float* w_out; const float* final_g;
    float* out; unsigned char* ws; int ph_lo, ph_hi;
};
typedef const __attribute__((address_space(4))) Args* KP;
__device__ __forceinline__ KP kargs() { KP p = (KP)__builtin_amdgcn_kernarg_segment_ptr(); asm volatile("" : "+s"(p)); return p; }

constexpr int BM = 256, BK = 64, HALF = 128, HTB = HALF * BK * 2, KSTEP = BK * 2;
__device__ __forceinline__ int lds_byte(int r, int c) { const int st = (r >> 4) * 2 + (c >> 5), rr = r & 15, cc = c & 31, ob = rr * 64 + cc * 2; return st * 1024 + (ob ^ (((ob >> 9) & 1) << 5)); }
__device__ __forceinline__ void stage_rc(int b, int& R, int& C) { const int st = b / 1024, sb = b % 1024, swz = sb ^ (((sb >> 9) & 1) << 5); R = (st >> 1) * 16 + swz / 64; C = (st & 1) * 32 + (swz % 64) / 2; }
__device__ __forceinline__ int perm32(int rho) { const int n = rho >> 4, i = rho & 15; return 8 * (i >> 2) + 4 * n + (i & 3); }

enum Mode { M_ACT = 0, M_GLU, M_MUL, M_MULSILU, M_X, M_GATE, M_YB, M_OUT };
enum Phase { PH_INPROJ = 0, PH_MIX = 2, PH_OUT = 3 };
struct Unit {
    const char* A; const char* B;
    int lda2, ldb2;
    int nt;
    int mode, pm, pn, aux;
    const float* ssp; const float* bip; int ssperm;
    int bperm;
};
#define XB_ARR(l)   (3408 + 16 * (l))
struct Sched {
    int phase, layer, G, c;
    unsigned* arr;
    __device__ __forceinline__ bool next(int i, Unit& u) const {
        const char* w = (const char*)kargs()->ws;
        if (phase == PH_INPROJ) {
            const int L = i * G + c; if (L >= 64 * 20) return false;
            const int xcd = L & 7, off = L >> 3;
            const int tm = 8 * xcd + (off & 7), tn = off >> 3;
            u.nt = 16; u.lda2 = 2048; u.ldb2 = 2048; u.bperm = 0;
            const float* ssl = (const float*)(w + WS_CTL + CTL_SS) + (size_t)layer * T; const float* bil = (const float*)(w + WS_CTL + CTL_BIAS) + (size_t)layer * NP;
            const char* xb = w + WS_XB + (size_t)tm * 256 * 2048;
            const char* wi = w + WS_WI + (size_t)layer * NP * 2048;
            if (tn < 16) {
                u.A = xb; u.B = wi + (size_t)(1024 + 256 * tn) * 2048; u.pm = tm; u.pn = tn;
                u.mode = (tn < 2) ? M_ACT : (tn < 6) ? M_GLU : (tn < 8) ? M_ACT : (tn < 12) ? M_MUL : M_MULSILU;
                u.aux = (tn < 2) ? tn : (tn < 6) ? tn - 2 : (tn < 8) ? tn - 6 : (tn < 12) ? tn - 8 : tn - 12;
                u.ssp = ssl + tm * 256; u.bip = bil + 1024 + 256 * tn; u.ssperm = 0;
            } else {
                u.A = wi + (size_t)(256 * (tn - 16)) * 2048; u.B = w + WS_XB + ((size_t)(tm >> 3) * 2048 + 4 * (tm & 7)) * 2048; u.pm = tn - 16; u.pn = tm; u.mode = M_X; u.aux = 0; u.bperm = 1;
                u.ssp = ssl + (size_t)(tm >> 3) * 2048 + 4 * (tm & 7); u.bip = bil + 256 * (tn - 16); u.ssperm = 1;
            }
            return true;
        } else {
            const int per = (phase == PH_MIX) ? 6 : 1;
            const int tl = c + (i / per) * G, sub = i % per; if (tl >= 256) return false;
            const int xcd = tl & 7, q = tl >> 3;
            u.pm = 8 * xcd + (q >> 2); u.pn = q & 3; u.bperm = 0; u.ssp = nullptr; u.bip = nullptr; u.ssperm = 0;
            if (phase == PH_OUT) {
                u.A = w + WS_REG + (size_t)(u.pm >> 3) * REG_B + REG_M + (size_t)(u.pm & 7) * 256 * 2048; u.B = w + WS_WO + ((size_t)layer * 1024 + 256 * u.pn) * 2048; u.lda2 = 2048; u.ldb2 = 2048; u.nt = 16; u.mode = M_OUT; u.aux = 0;
            } else if (sub < 3) {
                u.A = w + WS_XB + (size_t)u.pm * 256 * 2048; u.B = w + WS_WI + ((size_t)layer * NP + 5120 + 1024 * sub + 256 * u.pn) * 2048; u.lda2 = 2048; u.ldb2 = 2048; u.nt = 16; u.mode = M_GATE; u.aux = sub;
                u.ssp = (const float*)(w + WS_CTL + CTL_SS) + (size_t)layer * T + u.pm * 256; u.bip = (const float*)(w + WS_CTL + CTL_BIAS) + (size_t)layer * NP + 5120 + 1024 * sub + 256 * u.pn;
            } else {
                const int k = sub - 3;
                u.A = w + WS_Y + (size_t)u.pm * 256 * 3072 + k * 1024; u.B = w + WS_WB + (((size_t)layer * 3 + k) * 1024 + 256 * u.pn) * 1024; u.lda2 = 3072; u.ldb2 = 1024; u.nt = 8; u.mode = M_YB; u.aux = k;
            }
            return true;
        }
    }
};

template <int MODE> __device__ __forceinline__ void epi_tok(const f32x4 (&acc)[2][2][4][2], const Unit& u, unsigned char* ws, const LAS float* ssS, const LAS float* biasS, int rl0, int cl0) {
    f32x4 bv[2][2];
#pragma unroll
    for (int bj = 0; bj < 2; ++bj)
#pragma unroll
        for (int n = 0; n < 2; ++n) bv[bj][n] = *(const LAS f32x4*)(biasS + 128 * bj + cl0 + 4 * n);
    h16* dst; int ld, colbase;
    unsigned char* reg = ws + WS_REG + (size_t)(u.pm >> 3) * REG_B;
    if (MODE == M_GATE) { dst = (h16*)reg; ld = 3072; colbase = 1024 * u.aux + 256 * u.pn; }
    else if (MODE == M_ACT) { dst = (h16*)(reg + REG_PA + (u.pn < 2 ? 0 : 2) * PA_STEP); ld = 512; colbase = 256 * u.aux; }
    else { dst = (h16*)(reg + REG_PA + (MODE == M_GLU ? 1 : MODE == M_MUL ? 3 : 4) * PA_STEP); ld = 512; colbase = 128 * u.aux; }
    float rs[2][4];
#pragma unroll
    for (int ai = 0; ai < 2; ++ai)
#pragma unroll
        for (int m = 0; m < 4; ++m) rs[ai][m] = rsqrtf(ssS[128 * ai + 16 * m + rl0] * (1.f / D) + EPS);
#pragma unroll
    for (int ai = 0; ai < 2; ++ai)
#pragma unroll
        for (int m = 0; m < 4; ++m) {
            const int row = (u.pm & 7) * 256 + 128 * ai + 16 * m + rl0;
            const float r1 = rs[ai][m];
            h16* rowp = dst + (size_t)row * ld + colbase + cl0;
            const unsigned rowb = (unsigned)(row * ld + colbase + cl0) * 2u;
            if (MODE == M_ACT || MODE == M_GATE) {
#pragma unroll
                for (int bj = 0; bj < 2; ++bj) {
                    f32x4 v0 = acc[ai][bj][m][0] * r1 + bv[bj][0], v1 = acc[ai][bj][m][1] * r1 + bv[bj][1];
                    if (MODE == M_GATE) { v0 = sigden4(v0); v1 = sigden4(v1); }
                    u32x4 wv; wv.x = pkh(v0[0], v0[1]); wv.y = pkh(v0[2], v0[3]); wv.z = pkh(v1[0], v1[1]); wv.w = pkh(v1[2], v1[3]);
                    if (MODE == M_GATE) *(u32x4*)(reg + gs_native(u.pm, u.pn, u.aux, rl0, cl0) + 8192 * ((ai * 4 + m) * 2 + bj)) = wv;
                    else *(u32x4*)(rowp + 128 * bj) = wv;
                }
            } else {
                f32x4 o[2];
#pragma unroll
                for (int n = 0; n < 2; ++n) {
                    const f32x4 a = acc[ai][0][m][n] * r1 + bv[0][n], b = acc[ai][1][m][n] * r1 + bv[1][n];
                    if (MODE == M_GLU) o[n] = a * sigmoid4(b);
                    else if (MODE == M_MUL) o[n] = a * b;
                    else o[n] = a * b * sigmoid4(b);
                }
                u32x4 wv; wv.x = pkh(o[0][0], o[0][1]); wv.y = pkh(o[0][2], o[0][3]); wv.z = pkh(o[1][0], o[1][1]); wv.w = pkh(o[1][2], o[1][3]);
                *(u32x4*)rowp = wv;
            }
        }
}
__device__ __forceinline__ void epilogue(const f32x4 (&acc)[2][2][4][2], const Unit& u, KP P, LAS unsigned char* lds, int layer, int wr, int wc, int fr, int fq) {
    unsigned char* ws = P->ws;
    const LAS float* ssS = (const LAS float*)(lds + EPI_SS_OFF);
    const LAS float* biasS = (const LAS float*)(lds + EPI_BIAS_OFF);
    const int rl0 = opq_v(wr * 64 + fr);
    const int cl0 = opq_v(wc * 32 + 8 * fq);
    const int mode = u.mode;
    if (mode == M_ACT) { epi_tok<M_ACT>(acc, u, ws, ssS, biasS, rl0, cl0); return; }
    if (mode == M_GATE) { epi_tok<M_GATE>(acc, u, ws, ssS, biasS, rl0, cl0); return; }
    if (mode == M_GLU) { epi_tok<M_GLU>(acc, u, ws, ssS, biasS, rl0, cl0); return; }
    if (mode == M_MUL) { epi_tok<M_MUL>(acc, u, ws, ssS, biasS, rl0, cl0); return; }
    if (mode == M_MULSILU) { epi_tok<M_MULSILU>(acc, u, ws, ssS, biasS, rl0, cl0); return; }
    if (mode == M_X) {
        const int b = u.pn >> 3, pj = u.pn & 7, n10 = 256 * pj;
        f32x4 rc[2][2];
#pragma unroll
        for (int bj = 0; bj < 2; ++bj)
#pragma unroll
            for (int n = 0; n < 2; ++n) {
                const f32x4 s4 = *(const LAS f32x4*)(ssS + 128 * bj + cl0 + 4 * n);
#pragma unroll
                for (int e = 0; e < 4; ++e) rc[bj][n][e] = rsqrtf(s4[e] * (1.f / D) + EPS);
            }
        h16* xt = (h16*)(ws + WS_REG + (size_t)b * REG_B);
#pragma unroll
        for (int ai = 0; ai < 2; ++ai)
#pragma unroll
            for (int m = 0; m < 4; ++m) {
                const int wrow = u.pm * 256 + 128 * ai + 16 * m + rl0;
                const float bvr = biasS[128 * ai + 16 * m + rl0];
                const unsigned rowb = (unsigned)(wrow * 2048 + n10 + cl0) * 2u;
#pragma unroll
                for (int bj = 0; bj < 2; ++bj) {
                    const f32x4 v0 = acc[ai][bj][m][0] * rc[bj][0] + bvr, v1 = acc[ai][bj][m][1] * rc[bj][1] + bvr;
                    u32x4 wv; wv.x = pkh(v0[0], v0[1]); wv.y = pkh(v0[2], v0[3]); wv.z = pkh(v1[0], v1[1]); wv.w = pkh(v1[2], v1[3]);
                    *(u32x4*)((unsigned char*)xt + rowb + 256u * bj) = wv;
                }
                asm volatile("" ::: "memory");
            }
        return;
    }
    if (mode == M_YB) {
        if (u.aux < 2) return;
        unsigned char* reg = ws + WS_REG + (size_t)(u.pm >> 3) * REG_B;
        const unsigned char* g2 = reg + gs_native(u.pm, u.pn, 2, rl0, cl0);
        h16* Mo = (h16*)(reg + REG_M);
#pragma unroll
        for (int ai = 0; ai < 2; ++ai) {
            u32x4 gA[4][2];
#pragma unroll
            for (int m = 0; m < 4; ++m)
#pragma unroll
                for (int bj = 0; bj < 2; ++bj) gA[m][bj] = *(const u32x4*)(g2 + 8192 * ((ai * 4 + m) * 2 + bj));
            __builtin_amdgcn_sched_barrier(0);
#pragma unroll
            for (int m = 0; m < 4; ++m) {
                const size_t row = (size_t)(u.pm & 7) * 256 + 128 * ai + 16 * m + rl0;
                h16* gp = Mo + row * 1024 + 256 * u.pn + cl0;
#pragma unroll
                for (int bj = 0; bj < 2; ++bj) {
                    const u32x4 ga = gA[m][bj];
                    const f32x2 a0 = unpkh(ga.x), a1 = unpkh(ga.y), a2 = unpkh(ga.z), a3 = unpkh(ga.w);
                    const f32x4 v0 = acc[ai][bj][m][0], v1 = acc[ai][bj][m][1];
#define RC(x) __builtin_amdgcn_rcpf(x)
                    u32x4 wv; wv.x = pkh(v0[0] * RC(a0.x), v0[1] * RC(a0.y)); wv.y = pkh(v0[2] * RC(a1.x), v0[3] * RC(a1.y)); wv.z = pkh(v1[0] * RC(a2.x), v1[1] * RC(a2.y)); wv.w = pkh(v1[2] * RC(a3.x), v1[3] * RC(a3.y));
#undef RC
                    *(u32x4*)(gp + 128 * bj) = wv;
                }
                asm volatile("" ::: "memory");
            }
        }
        return;
    }
    {
        h16* xb = (h16*)(ws + WS_XB);
        float* ssn = (float*)(ws + WS_CTL + CTL_SS) + (size_t)(layer + 1) * T;
#pragma unroll
        for (int ai = 0; ai < 2; ++ai) {
            u32x4 rV[4][2];
#pragma unroll
            for (int m = 0; m < 4; ++m)
#pragma unroll
                for (int bj = 0; bj < 2; ++bj) rV[m][bj] = *(const u32x4*)(xb + ((size_t)u.pm * 256 + 128 * ai + 16 * m + rl0) * 1024 + 256 * u.pn + cl0 + 128 * bj);
            __builtin_amdgcn_sched_barrier(0);
#pragma unroll
            for (int m = 0; m < 4; ++m) {
                const size_t row = (size_t)u.pm * 256 + 128 * ai + 16 * m + rl0;
                const size_t off = row * 1024 + 256 * u.pn + cl0;
                float sq = 0.f;
#pragma unroll
                for (int bj = 0; bj < 2; ++bj) {
                    const u32x4 rv = rV[m][bj];
                    const f32x2 a0 = unpkh(rv.x), a1 = unpkh(rv.y), a2 = unpkh(rv.z), a3 = unpkh(rv.w);
                    const f32x4 v0 = (f32x4){a0.x, a0.y, a1.x, a1.y} + acc[ai][bj][m][0], v1 = (f32x4){a2.x, a2.y, a3.x, a3.y} + acc[ai][bj][m][1];
                    u32x4 wv; wv.x = pkh(v0[0], v0[1]); wv.y = pkh(v0[2], v0[3]); wv.z = pkh(v1[0], v1[1]); wv.w = pkh(v1[2], v1[3]);
                    *(u32x4*)(xb + off + 128 * bj) = wv;
                    sq += (v0[0] * v0[0] + v0[1] * v0[1]) + (v0[2] * v0[2] + v0[3] * v0[3]) + (v1[0] * v1[0] + v1[1] * v1[1]) + (v1[2] * v1[2] + v1[3] * v1[3]);
                }
                sq += __shfl_xor(sq, 16); sq += __shfl_xor(sq, 32);
                if (fq == 0) atomicAdd(ssn + row, sq);
                if (m == 3) asm volatile("" ::: "memory");
            }
        }
        return;
    }
}
constexpr int EX_P_OFF = 131072, EX_S_OFF = EX_P_OFF + 4096, EX_FLAG_OFF = EX_S_OFF + 1024;
__device__ __forceinline__ void epi_out_last(f32x4 (&acc)[2][2][4][2], const Unit& u, KP P, LAS unsigned char* lds, int wr, int wc, int fr, int fq) {
    unsigned char* ws = P->ws;
    const int tid = opq_v(threadIdx.x), wid = __builtin_amdgcn_readfirstlane(tid >> 6), lane = tid & 63;
    const int rl0 = opq_v(wr * 64 + fr), cl0 = opq_v(wc * 32 + 8 * fq);
    const h16* xb = (const h16*)(ws + WS_XB);
    LAS float* Pt = (LAS float*)(lds + EX_P_OFF);
    LAS float* St = (LAS float*)(lds + EX_S_OFF);
    volatile LAS unsigned* flag = (volatile LAS unsigned*)(lds + EX_FLAG_OFF);
    float* slots = (float*)(ws + WS_CTL + CTL_XS);
    unsigned* cnt = (unsigned*)(ws + WS_CTL + CTL_XCNT) + 64 * u.pm;
#pragma unroll
    for (int ai = 0; ai < 2; ++ai) {
        u32x4 rV[4][2];
#pragma unroll
        for (int m = 0; m < 4; ++m)
#pragma unroll
            for (int bj = 0; bj < 2; ++bj) rV[m][bj] = *(const u32x4*)(xb + ((size_t)u.pm * 256 + 128 * ai + 16 * m + rl0) * 1024 + 256 * u.pn + cl0 + 128 * bj);
        __builtin_amdgcn_sched_barrier(0);
#pragma unroll
        for (int m = 0; m < 4; ++m) {
            float sq = 0.f;
#pragma unroll
            for (int bj = 0; bj < 2; ++bj) {
                const u32x4 rv = rV[m][bj];
                const f32x2 a0 = unpkh(rv.x), a1 = unpkh(rv.y), a2 = unpkh(rv.z), a3 = unpkh(rv.w);
                f32x4 v0 = acc[ai][bj][m][0], v1 = acc[ai][bj][m][1];
                v0[0] += a0.x; v0[1] += a0.y; v0[2] += a1.x; v0[3] += a1.y; v1[0] += a2.x; v1[1] += a2.y; v1[2] += a3.x; v1[3] += a3.y;
                acc[ai][bj][m][0] = v0; acc[ai][bj][m][1] = v1;
                sq += (v0[0] * v0[0] + v0[1] * v0[1]) + (v0[2] * v0[2] + v0[3] * v0[3]) + (v1[0] * v1[0] + v1[1] * v1[1]) + (v1[2] * v1[2] + v1[3] * v1[3]);
            }
            sq += __shfl_xor(sq, 16); sq += __shfl_xor(sq, 32);
            if (fq == 0) Pt[(128 * ai + 16 * m + rl0) * 4 + wc] = sq;
            asm volatile("" : "+v"(acc[ai][0][m][0]), "+v"(acc[ai][0][m][1]), "+v"(acc[ai][1][m][0]), "+v"(acc[ai][1][m][1]) :: "memory");
        }
    }
    asm volatile("s_waitcnt lgkmcnt(0)" ::: "memory"); __builtin_amdgcn_s_barrier(); asm volatile("" ::: "memory");
    if (tid < 256) {
        const f32x4 p4 = *(const LAS f32x4*)(Pt + tid * 4);
        __hip_atomic_store(slots + ((size_t)u.pm * 4 + u.pn) * 256 + tid, (p4[0] + p4[1]) + (p4[2] + p4[3]), __ATOMIC_RELAXED, __HIP_MEMORY_SCOPE_AGENT);
        asm volatile("s_waitcnt vmcnt(0)" ::: "memory");
        if (lane == 0) __hip_atomic_fetch_add(cnt, 1u, __ATOMIC_RELAXED, __HIP_MEMORY_SCOPE_AGENT);
    }
    if (wid == 0) {
        unsigned sp = 0; bool dead = false;
        while ((unsigned)__builtin_amdgcn_readfirstlane(__hip_atomic_load(cnt, __ATOMIC_RELAXED, __HIP_MEMORY_SCOPE_AGENT)) < 16u) {
            __builtin_amdgcn_s_sleep(2);
            if (++sp > (1u << 20)) { dead = true; break; }
        }
        __builtin_amdgcn_fence(__ATOMIC_ACQUIRE, "agent");
        if (lane == 0) { flag[0] = dead ? 1u : 0u; if (dead) __hip_atomic_store((unsigned*)(ws + WS_CTL + CTL_BAR) + XB_TMO, 1u, __ATOMIC_RELAXED, __HIP_MEMORY_SCOPE_AGENT); }
    }
    asm volatile("s_waitcnt vmcnt(0) lgkmcnt(0)" ::: "memory"); __builtin_amdgcn_s_barrier(); asm volatile("" ::: "memory");
    if (tid < 256) {
        const float* sl = slots + (size_t)u.pm * 4 * 256 + tid;
        float tot = 0.f;
#pragma unroll
        for (int t = 0; t < 4; ++t) tot += __hip_atomic_load(sl + t * 256, __ATOMIC_RELAXED, __HIP_MEMORY_SCOPE_AGENT);
        St[tid] = rsqrtf(tot * (1.f / D) + EPS);
    }
    asm volatile("s_waitcnt lgkmcnt(0)" ::: "memory"); __builtin_amdgcn_s_barrier(); asm volatile("" ::: "memory");
    f32x4 gv[2][2];
#pragma unroll
    for (int bj = 0; bj < 2; ++bj)
#pragma unroll
        for (int n = 0; n < 2; ++n) gv[bj][n] = *(const f32x4*)(P->final_g + 256 * u.pn + 128 * bj + cl0 + 4 * n);
    float* xo = P->out;
#pragma unroll
    for (int ai = 0; ai < 2; ++ai)
#pragma unroll
        for (int m = 0; m < 4; ++m) {
            const int rl = 128 * ai + 16 * m + rl0;
            const float rs = St[rl];
            const size_t off = ((size_t)u.pm * 256 + rl) * 1024 + 256 * u.pn + cl0;
#pragma unroll
            for (int bj = 0; bj < 2; ++bj) { *(f32x4*)(xo + off + 128 * bj) = acc[ai][bj][m][0] * rs * gv[bj][0]; *(f32x4*)(xo + off + 128 * bj + 4) = acc[ai][bj][m][1] * rs * gv[bj][1]; }
        }
}
__device__ __forceinline__ void acc_handover(f32x4 (&acc)[2][2][4][2], const Unit& u, KP P, int wr, int wc, int fr, int fq) {
    unsigned char* ws = P->ws;
    const bool keep = (u.mode == M_YB) && (u.aux < 2);
    {
        int zi = __builtin_amdgcn_readfirstlane(keep ? 0x3f800000 : 0);
        asm volatile("" : "+s"(zi));
        const float z = __builtin_bit_cast(float, zi);
#pragma unroll
        for (int ai = 0; ai < 2; ++ai)
#pragma unroll
            for (int bj = 0; bj < 2; ++bj)
#pragma unroll
                for (int m = 0; m < 4; ++m) { acc[ai][bj][m][0] *= z; acc[ai][bj][m][1] *= z; }
    }
    if (!keep) return;
    const int rl0 = opq_v(wr * 64 + fr), cl0 = opq_v(wc * 32 + 8 * fq);
    const unsigned char* gk = ws + WS_REG + (size_t)(u.pm >> 3) * REG_B + gs_native(u.pm, u.pn, u.aux, rl0, cl0);
#pragma unroll
    for (int ai = 0; ai < 2; ++ai) {
        u32x4 gA[4][2], gB[4][2];
#pragma unroll
        for (int m = 0; m < 4; ++m)
#pragma unroll
            for (int bj = 0; bj < 2; ++bj) { gA[m][bj] = *(const u32x4*)(gk + 8192 * ((ai * 4 + m) * 2 + bj)); gB[m][bj] = *(const u32x4*)(gk + 131072 + 8192 * ((ai * 4 + m) * 2 + bj)); }
        __builtin_amdgcn_sched_barrier(0);
#pragma unroll
        for (int m = 0; m < 4; ++m) {
#pragma unroll
            for (int bj = 0; bj < 2; ++bj) {
                const u32x4 ga = gA[m][bj], gb = gB[m][bj];
                const f32x2 a0 = unpkh(ga.x), a1 = unpkh(ga.y), a2 = unpkh(ga.z), a3 = unpkh(ga.w), b0 = unpkh(gb.x), b1 = unpkh(gb.y), b2 = unpkh(gb.z), b3 = unpkh(gb.w);
                acc[ai][bj][m][0][0] *= b0.x * __builtin_amdgcn_rcpf(a0.x); acc[ai][bj][m][0][1] *= b0.y * __builtin_amdgcn_rcpf(a0.y);
                acc[ai][bj][m][0][2] *= b1.x * __builtin_amdgcn_rcpf(a1.x); acc[ai][bj][m][0][3] *= b1.y * __builtin_amdgcn_rcpf(a1.y);
                acc[ai][bj][m][1][0] *= b2.x * __builtin_amdgcn_rcpf(a2.x); acc[ai][bj][m][1][1] *= b2.y * __builtin_amdgcn_rcpf(a2.y);
                acc[ai][bj][m][1][2] *= b3.x * __builtin_amdgcn_rcpf(a3.x); acc[ai][bj][m][1][3] *= b3.y * __builtin_amdgcn_rcpf(a3.y);
            }
            if (m == 3) asm volatile("" : "+v"(acc[ai][0][0][0]), "+v"(acc[ai][0][0][1]), "+v"(acc[ai][1][0][0]), "+v"(acc[ai][1][0][1]), "+v"(acc[ai][0][1][0]), "+v"(acc[ai][0][1][1]), "+v"(acc[ai][1][1][0]), "+v"(acc[ai][1][1][1]),
                                             "+v"(acc[ai][0][2][0]), "+v"(acc[ai][0][2][1]), "+v"(acc[ai][1][2][0]), "+v"(acc[ai][1][2][1]), "+v"(acc[ai][0][3][0]), "+v"(acc[ai][0][3][1]), "+v"(acc[ai][1][3][0]), "+v"(acc[ai][1][3][1]) :: "memory");
        }
    }
}

__device__ __forceinline__ void gemm_phase(LAS unsigned char* lds, const Sched& Sc, KP P) {
    const int tid = opq_v(threadIdx.x), wid = __builtin_amdgcn_readfirstlane(tid >> 6), lane = tid & 63, wr = wid >> 2, wc = wid & 3, fr = lane & 15, fq = lane >> 4;
    int rA[2], rB[2], rX[2], c2[2];
#pragma unroll
    for (int i = 0; i < 2; ++i) { int R, C; stage_rc(tid * 16 + i * 8192, R, C); rA[i] = R; rB[i] = (R & ~31) + perm32(R & 31); rX[i] = 32 * (rB[i] & 63) + (rB[i] >> 6); c2[i] = C * 2; }
    const unsigned ldsw = (unsigned)wid * 1024u;
    const int aoff = lds_byte(wr * 64 + fr, fq * 8), boff = lds_byte(wc * 32 + fr, fq * 8);
#define G_SA(b, h) (((b) * 2 + (h)) * HTB)
#define G_SB(b, h) ((4 + (b) * 2 + (h)) * HTB)
#define G_STAGE(bufoff, base, ld2, hrow, koff, r0, r1) do { \
        __builtin_amdgcn_global_load_lds((const unsigned*)((base) + (size_t)(unsigned)(((r0) + (hrow)) * (ld2) + c2[0] + (koff))), (LAS unsigned*)(lds + (bufoff) + ldsw), 16, 0, 0); \
        __builtin_amdgcn_global_load_lds((const unsigned*)((base) + (size_t)(unsigned)(((r1) + (hrow)) * (ld2) + c2[1] + (koff))), (LAS unsigned*)(lds + (bufoff) + ldsw + 8192), 16, 0, 0); } while (0)
#define G_STA(bufoff, base, ld2, h, koff) G_STAGE(bufoff, base, ld2, 128 * (h), koff, rA[0], rA[1])
#define G_LDA(dst, b, h) do { _Pragma("unroll") for (int m = 0; m < 4; ++m) _Pragma("unroll") for (int k = 0; k < 2; ++k) dst[m][k] = *(const LAS h16x8*)(lds + G_SA(b, h) + aoff + m * 2048 + k * 1024); } while (0)
#define G_LDB(dst, b, h) do { _Pragma("unroll") for (int n = 0; n < 2; ++n) _Pragma("unroll") for (int k = 0; k < 2; ++k) dst[n][k] = *(const LAS h16x8*)(lds + G_SB(b, h) + boff + n * 2048 + k * 1024); } while (0)
#define G_MMA(ai, bj, At, Bt) do { __builtin_amdgcn_s_setprio(1); _Pragma("unroll") for (int m = 0; m < 4; ++m) _Pragma("unroll") for (int n = 0; n < 2; ++n) _Pragma("unroll") for (int k = 0; k < 2; ++k) \
        acc[ai][bj][m][n] = MFMA16(Bt[n][k], At[m][k], acc[ai][bj][m][n]); __builtin_amdgcn_s_setprio(0); } while (0)
#define G_WAIT_V(n) asm volatile("s_waitcnt vmcnt(" #n ")" ::: "memory")
#define G_WAIT_L(n) asm volatile("s_waitcnt lgkmcnt(" #n ")" ::: "memory")
#define G_BAR __builtin_amdgcn_s_barrier()
#define G_SCHED __builtin_amdgcn_sched_barrier(0)
    Unit cur, nxt; int ui = 0;
    if (!Sc.next(0, cur)) return;
    f32x4 acc[2][2][4][2];
#pragma unroll
    for (int a = 0; a < 2; ++a)
#pragma unroll
        for (int b = 0; b < 2; ++b)
#pragma unroll
            for (int m = 0; m < 4; ++m)
#pragma unroll
                for (int n = 0; n < 2; ++n) acc[a][b][m][n] = (f32x4){0.f, 0.f, 0.f, 0.f};
    h16x8 At[4][2], B0[2][2], B1[2][2];
    { const int q0 = cur.bperm ? rX[0] : rB[0], q1 = cur.bperm ? rX[1] : rB[1], hm = cur.bperm ? 2 : 128;
      G_STAGE(G_SB(0, 0), cur.B, cur.ldb2, 0, 0, q0, q1); G_STAGE(G_SB(0, 1), cur.B, cur.ldb2, hm, 0, q0, q1); G_STA(G_SA(0, 0), cur.A, cur.lda2, 0, 0); G_STA(G_SA(0, 1), cur.A, cur.lda2, 1, 0);
      if (wr == 1) G_BAR;
      G_WAIT_V(2); G_BAR;
      G_STAGE(G_SB(1, 0), cur.B, cur.ldb2, 0, KSTEP, q0, q1); G_STAGE(G_SB(1, 1), cur.B, cur.ldb2, hm, KSTEP, q0, q1);
      G_WAIT_V(6); G_BAR; }
    for (;;) {
        const bool has_next = Sc.next(ui + 1, nxt);
        const char* nA = has_next ? nxt.A : cur.A; const char* nB = has_next ? nxt.B : cur.B;
        const int nlda = has_next ? nxt.lda2 : cur.lda2, nldb = has_next ? nxt.ldb2 : cur.ldb2, nbp = has_next ? nxt.bperm : cur.bperm;
        const int nt = cur.nt;
        for (int t = 0; t < nt; t += 2) {
            const bool last = (t == nt - 2);
            const int k1 = (t + 1) * KSTEP;
            const char* a2 = last ? nA : cur.A; const char* b2 = last ? nB : cur.B;
            const int la2 = last ? nlda : cur.lda2, lb2 = last ? nldb : cur.ldb2;
            const int k2 = last ? 0 : (t + 2) * KSTEP, k3 = k2 + KSTEP;
            const int bp2 = last ? nbp : cur.bperm;
            const int q0 = bp2 ? rX[0] : rB[0], q1 = bp2 ? rX[1] : rB[1], hm = bp2 ? 2 : 128;
            if (last && cur.ssp) {
                const int j = (wid & 3) * 64 + lane;
                const float* src = (wid < 4) ? cur.ssp + (cur.ssperm ? 32 * (j & 63) + (j >> 6) : j) : cur.bip + j;
                __builtin_amdgcn_global_load_lds((const unsigned*)src, (LAS unsigned*)(lds + (wid < 4 ? EPI_SS_OFF : EPI_BIAS_OFF) + (wid & 3) * 256), 4, 0, 0);
            }
            G_LDB(B0, 0, 0); G_LDB(B1, 0, 1); G_SCHED; G_LDA(At, 0, 0); G_STA(G_SA(1, 0), cur.A, cur.lda2, 0, k1); G_STA(G_SA(1, 1), cur.A, cur.lda2, 1, k1);
            G_WAIT_V(8); G_WAIT_L(0); G_BAR; G_MMA(0, 0, At, B0); G_MMA(0, 1, At, B1); G_BAR; G_SCHED;
            G_LDA(At, 0, 1); G_STAGE(G_SB(0, 0), b2, lb2, 0, k2, q0, q1); G_STAGE(G_SB(0, 1), b2, lb2, hm, k2, q0, q1);
            G_WAIT_V(6); G_WAIT_L(0); G_BAR; G_MMA(1, 0, At, B0); G_MMA(1, 1, At, B1); G_BAR; G_SCHED;
            G_LDB(B0, 1, 0); G_LDB(B1, 1, 1); G_SCHED; G_LDA(At, 1, 0); G_STA(G_SA(0, 0), a2, la2, 0, k2); G_STA(G_SA(0, 1), a2, la2, 1, k2);
            G_WAIT_V(8); G_WAIT_L(0); G_BAR; G_MMA(0, 0, At, B0); G_MMA(0, 1, At, B1); G_BAR; G_SCHED;
            G_LDA(At, 1, 1); G_STAGE(G_SB(1, 0), b2, lb2, 0, k3, q0, q1); G_STAGE(G_SB(1, 1), b2, lb2, hm, k3, q0, q1);
            G_WAIT_V(6); G_WAIT_L(0); G_BAR; G_MMA(1, 0, At, B0); G_MMA(1, 1, At, B1); G_BAR; G_SCHED;
        }
        if (ui == 0 && Sc.arr != nullptr && wid == 0) {
            XB_SPIN(xb_ld(&Sc.arr[XB_ARR(Sc.layer)]) < 32u, Sc.arr);
            asm volatile("buffer_inv sc1" ::: "memory");
        }
        if (wr == 0) G_BAR;
        if (cur.mode == M_OUT && Sc.layer == DEPTH - 1) epi_out_last(acc, cur, P, lds, wr, wc, fr, fq);
        else epilogue(acc, cur, P, lds, Sc.layer, wr, wc, fr, fq);
        if (!has_next) break;
        acc_handover(acc, cur, P, wr, wc, fr, fq);
        cur = nxt; ++ui;
        if (wr == 1) G_BAR;
    }
    G_WAIT_V(0);
    G_BAR;
#undef G_SA
#undef G_SB
#undef G_STAGE
#undef G_STA
#undef G_LDA
#undef G_LDB
#undef G_MMA
#undef G_WAIT_V
#undef G_WAIT_L
#undef G_BAR
#undef G_SCHED
}

__device__ __forceinline__ void p0_transpose_item(const float* W, int Nsrc, int k0, int c0, h16* dst, int dpitch, int r0, const float* gk, LAS float* scr, int lane) {
    float tv[32];
#pragma unroll
    for (int i = 0; i < 32; ++i) tv[i] = W[(size_t)(k0 + 2 * i + (lane >> 5)) * Nsrc + c0 + (lane & 31)];
    if (gk) {
#pragma unroll
        for (int i = 0; i < 32; ++i) tv[i] *= gk[k0 + 2 * i + (lane >> 5)]; }
#pragma unroll
    for (int i = 0; i < 32; ++i) scr[(2 * i + (lane >> 5)) * 33 + (lane & 31)] = tv[i];
    LDS_WAIT(); asm volatile("" ::: "memory");
    const int c = lane & 7;
#pragma unroll
    for (int j = 0; j < 4; ++j) { const int n = (lane >> 3) + 8 * j; const LAS float* s = scr + (8 * c) * 33 + n;
        u32x4 o; o.x = pkh(s[0 * 33], s[1 * 33]); o.y = pkh(s[2 * 33], s[3 * 33]); o.z = pkh(s[4 * 33], s[5 * 33]); o.w = pkh(s[6 * 33], s[7 * 33]);
        st16_wt(dst, (unsigned)((r0 + n) * dpitch + k0 + 8 * c) * 2u, o); }
    LDS_WAIT(); asm volatile("" ::: "memory");
}
__device__ __forceinline__ int inproj_col(int r) {
    if (r >= 5120) return 4608 + (r - 5120);
    const int j = (r - 1024) >> 8, q = (r - 1024) & 255, hf = q >> 7, i = q & 127;
    if (j < 2) return 512 + 256 * j + q;
    if (j < 6) return (hf ? 1536 : 1024) + 128 * (j - 2) + i;
    if (j < 8) return 2048 + 256 * (j - 6) + q;
    if (j < 12) return (hf ? 3584 : 3072) + 128 * (j - 8) + i;
    return (hf ? 4096 : 2560) + 128 * (j - 12) + i;
}
__device__ __forceinline__ void p0_fold_item(KP P, int item, LAS unsigned char* lds) {
    const int tid = opq_v(threadIdx.x); unsigned char* ws = P->ws;
    const int l = item >> 7, gr = (item >> 5) & 3, kb = item & 31, k0 = kb * 32;
    LAS float* Wt = (LAS float*)lds;
    LAS float* cosT = Wt + 128 * 36; LAS float* sinT = cosT + 128;
    const float* W = P->w_in + (size_t)l * D * INW;
    const float* g = P->norm_g + l * D;
    __syncthreads();
    if (tid < 128) { cosT[tid] = cospif(tid * (1.f / 64.f)); sinT[tid] = sinpif(tid * (1.f / 64.f)); }
#pragma unroll
    for (int j = 0; j < 8; ++j) { const int n2 = tid & 127, kk = (tid >> 7) + 4 * j; Wt[n2 * 36 + kk] = W[(size_t)(k0 + kk) * INW + gr * 128 + n2] * g[k0 + kk]; }
    __syncthreads();
    const int pp = tid & 63, kq = __builtin_amdgcn_readfirstlane(tid >> 6);
    f32x4 ec = {0.f, 0.f, 0.f, 0.f}, es = ec, oc = ec, os = ec;
    float bec = 0.f, bes = 0.f, boc = 0.f, bos = 0.f;
    const float* bin = P->b_in + (size_t)l * INW + gr * 128;
    const bool dob = (kb == 0 && kq == 0);
#pragma unroll 4
    for (int m = 0; m < 64; ++m) {
        const int ie = (pp * 2 * m) & 127, io = (pp * (2 * m + 1)) & 127;
        const float ce = cosT[ie], se = sinT[ie], co = cosT[io], so = sinT[io];
        const f32x4 we = *(const LAS f32x4*)(Wt + (2 * m) * 36 + kq * 4), wo = *(const LAS f32x4*)(Wt + (2 * m + 1) * 36 + kq * 4);
        ec += we * ce; es += we * se; oc += wo * co; os += wo * so;
        if (dob) { const float b0 = bin[2 * m], b1 = bin[2 * m + 1]; bec += b0 * ce; bes += b0 * se; boc += b1 * co; bos += b1 * so; }
    }
    h16* wi = (h16*)(ws + WS_WI) + (size_t)l * NP * 1024;
    const int r0 = 2 * (gr * 128 + pp), r1 = r0 + 128;
    { const f32x4 c0 = ec + oc, s0 = es + os, c1 = ec - oc, s1 = es - os;
      u32x2 o; o.x = pkh(c0[0], c0[1]); o.y = pkh(c0[2], c0[3]); st8_wt(wi, (unsigned)(r0 * 1024 + k0 + kq * 4) * 2u, o);
      o.x = pkh(s0[0], s0[1]); o.y = pkh(s0[2], s0[3]); st8_wt(wi, (unsigned)((r0 + 1) * 1024 + k0 + kq * 4) * 2u, o);
      o.x = pkh(c1[0], c1[1]); o.y = pkh(c1[2], c1[3]); st8_wt(wi, (unsigned)(r1 * 1024 + k0 + kq * 4) * 2u, o);
      o.x = pkh(s1[0], s1[1]); o.y = pkh(s1[2], s1[3]); st8_wt(wi, (unsigned)((r1 + 1) * 1024 + k0 + kq * 4) * 2u, o); }
    if (dob) { float* biasP = (float*)(ws + WS_CTL + CTL_BIAS) + (size_t)l * NP;
        __hip_atomic_store(biasP + r0, bec + boc, __ATOMIC_RELAXED, __HIP_MEMORY_SCOPE_AGENT); __hip_atomic_store(biasP + r0 + 1, bes + bos, __ATOMIC_RELAXED, __HIP_MEMORY_SCOPE_AGENT);
        __hip_atomic_store(biasP + r1, bec - boc, __ATOMIC_RELAXED, __HIP_MEMORY_SCOPE_AGENT); __hip_atomic_store(biasP + r1 + 1, bes - bos, __ATOMIC_RELAXED, __HIP_MEMORY_SCOPE_AGENT); }
}
__device__ __forceinline__ void p0_weights(KP P, LAS unsigned char* lds, int c, int G, int l) {
    const int tid = opq_v(threadIdx.x), lane = tid & 63, wave = __builtin_amdgcn_readfirstlane(tid >> 6); unsigned char* ws = P->ws;
    for (int it = c; it < 128; it += G) p0_fold_item(P, 128 * l + it, lds);
    __syncthreads();
    LAS float* scr = (LAS float*)(lds + wave * 16384);
    const int gw = c * NWAVES + wave, NGW = G * NWAVES;
    constexpr int I_WI = 16 * 224, I_WB = 8 * 32, I_WO = 16 * 32;
    constexpr int NITEMS = I_WI + 3 * I_WB + I_WO;
    const bool bal = (G == 256);
    const int half_w = 128 * NWAVES, first_n = 4 * half_w;
    const int it0 = bal ? (c >= 128 ? gw - half_w : first_n + gw) : gw, its = bal ? half_w : NGW, itend = bal ? (c >= 128 ? first_n : NITEMS) : NITEMS;
    for (int it = it0; it < itend; it += its) {
        int r = it;
        if (r < I_WI) { const int kb = r / 224, rb = r % 224, r0 = 1024 + 32 * rb;
            p0_transpose_item(P->w_in + (size_t)l * D * INW, INW, 64 * kb, inproj_col(r0), (h16*)(ws + WS_WI) + (size_t)l * NP * 1024, 1024, r0, P->norm_g + l * D, scr, lane); continue; }
        r -= I_WI;
        if (r < 3 * I_WB) { const int lk = 3 * l + r / I_WB; r %= I_WB; const int kb = r / 32, rb = r % 32;
            p0_transpose_item(P->w_branch + (size_t)lk * BW * D, D, 64 * kb, 32 * rb, (h16*)(ws + WS_WB) + (size_t)lk * 1024 * 512, 512, 32 * rb, nullptr, scr, lane); continue; }
        r -= 3 * I_WB;
        { const int kb = r / 32, rb = r % 32;
            p0_transpose_item(P->w_out + (size_t)l * D * D, D, 64 * kb, 32 * rb, (h16*)(ws + WS_WO) + (size_t)l * 1024 * 1024, 1024, 32 * rb, nullptr, scr, lane); }
    }
    { float* biasP = (float*)(ws + WS_CTL + CTL_BIAS) + (size_t)l * NP;
      for (int i = c * NTHREADS + tid; i < NP - 1024; i += G * NTHREADS) { const int r = 1024 + i; __hip_atomic_store(biasP + r, P->b_in[(size_t)l * INW + inproj_col(r)], __ATOMIC_RELAXED, __HIP_MEMORY_SCOPE_AGENT); } }
    __syncthreads();
}
__device__ __forceinline__ void fft_build_tables(KP P, LAS unsigned char* lds, int part);
__device__ __forceinline__ void p0_prologue(KP P, LAS unsigned char* lds, int c, int G) {
    p0_weights(P, lds, c, G, 0);
    const int tid = opq_v(threadIdx.x), lane = tid & 63, wave = __builtin_amdgcn_readfirstlane(tid >> 6); unsigned char* ws = P->ws;
    const int gw = c * NWAVES + wave, NGW = G * NWAVES;
    if (c >= G - 32) fft_build_tables(P, lds, c - (G - 32));
    { float* ss1 = (float*)(ws + WS_CTL + CTL_SS) + T; for (int i = c * NTHREADS + tid; i < T; i += G * NTHREADS) ss1[i] = 0.f;
      unsigned* xc = (unsigned*)(ws + WS_CTL + CTL_XCNT); for (int i = c * NTHREADS + tid; i < 4096; i += G * NTHREADS) xc[i] = 0u;
      if (c == 1 && tid < 128) ((unsigned*)(ws + WS_CTL + CTL_DUMMY))[tid] = 0u;
      if (c >= 8 && c < 16) { unsigned* gb = (unsigned*)(ws + WS_CTL + CTL_GBAR) + 4096 * (c - 8); for (int i = tid; i < XCD_BAR_WORDS; i += NTHREADS) gb[i] = 0u; }
      if (c == 16 && tid < 16) ((unsigned*)(ws + WS_CTL + CTL_PREP))[tid] = 0u; }
    if (c == 0 && tid < 128) ((unsigned*)(ws + WS_CTL + CTL_DUMMY + 2048))[tid] = USE_BF16 ? 0x3F803F80u : 0x3C003C00u;
    if (c == 0 && tid == 128) *(float*)(ws + WS_CTL + CTL_DUMMY + 2048 + 512) = 1.0f;
    { float* ss0 = (float*)(ws + WS_CTL + CTL_SS); h16* xb = (h16*)(ws + WS_XB);
      for (int row = gw; row < T; row += 2 * NGW) {
          const int row2 = row + NGW;
          const f32x4* xr = (const f32x4*)(P->x + (size_t)row * D) + lane; const f32x4* xq = (const f32x4*)(P->x + (size_t)(row2 < T ? row2 : row) * D) + lane;
          f32x4 v[4], w[4]; float s = 0.f, s2 = 0.f;
#pragma unroll
          for (int j = 0; j < 4; ++j) { v[j] = xr[64 * j]; w[j] = xq[64 * j]; }
#pragma unroll
          for (int j = 0; j < 4; ++j) { s += (v[j][0] * v[j][0] + v[j][1] * v[j][1]) + (v[j][2] * v[j][2] + v[j][3] * v[j][3]); s2 += (w[j][0] * w[j][0] + w[j][1] * w[j][1]) + (w[j][2] * w[j][2] + w[j][3] * w[j][3]); }
          s = wave_sum(s); s2 = wave_sum(s2);
          if (lane == 0) { ss0[row] = s; if (row2 < T) ss0[row2] = s2; }
          u32x2* o = (u32x2*)(xb + (size_t)row * D) + lane;
#pragma unroll
          for (int j = 0; j < 4; ++j) { u32x2 t; t.x = pkh(v[j][0], v[j][1]); t.y = pkh(v[j][2], v[j][3]); o[64 * j] = t; }
          if (row2 < T) { u32x2* o2 = (u32x2*)(xb + (size_t)row2 * D) + lane;
#pragma unroll
              for (int j = 0; j < 4; ++j) { u32x2 t; t.x = pkh(w[j][0], w[j][1]); t.y = pkh(w[j][2], w[j][3]); o2[64 * j] = t; } }
      } }
}
constexpr int FFT_W1_OFF = 0, FFT_TW_OFF = 32768, FFT_ST_OFF = 49152, FFT_LUT_OFF = FFT_ST_OFF + 65536;
static_assert(FFT_LUT_OFF + 256 <= MISC_OFF, "lds map (fft)");
__device__ __forceinline__ void fft_build_tables(KP P, LAS unsigned char* lds, int part) {
    const int tid = opq_v(threadIdx.x);
    unsigned char* tab = P->ws + WS_TAB;
    if (part == 0 && tid < 64) ((float*)(tab + 49152))[tid] = cospif(tid * (1.f / 32.f));
    {
        const int idx = part * NTHREADS + tid;
        const int frag = idx >> 9, nt = frag >> 2, st = frag & 3, ln = (idx >> 3) & 63, e = idx & 7;
        const int kk = 32 * st + 8 * (ln >> 4) + e, j = 16 * nt + (ln & 15), csi = kk >> 6, n_hi = kk & 63, reim = j >> 6, k_lo = j & 63, a = (k_lo * n_hi) & 63;
        const float c = cospif(a * (1.f / 32.f)), sn = sinpif(a * (1.f / 32.f));
        ((h16*)tab)[idx] = (h16)(reim == 0 ? (csi == 0 ? c : -sn) : (csi == 0 ? -sn : -c));
    }
    if (tid < 64) {
        const int idx = part * 64 + tid; const float x = (float)((idx >> 6) * (idx & 63)) * (1.f / 1024.f);
        ((f32x2*)(tab + 32768))[idx] = (f32x2){cospif(x), sinpif(x)};
    }
}
static_assert(FFT_W1_OFF == 0 && FFT_TW_OFF == 32768, "table image layout");
__device__ __forceinline__ void fft_load_tables(KP P, LAS unsigned char* lds) {
    const int tid = opq_v(threadIdx.x);
    const u32x4* src = (const u32x4*)(P->ws + WS_TAB);
    __syncthreads();
    u32x4 v[6];
#pragma unroll
    for (int i = 0; i < 6; ++i) v[i] = src[tid + i * NTHREADS];
#pragma unroll
    for (int i = 0; i < 6; ++i) *(LAS u32x4*)(lds + (tid + i * NTHREADS) * 16) = v[i];
    if (tid < 16) *(LAS u32x4*)(lds + FFT_LUT_OFF + tid * 16) = src[3072 + tid];
    __syncthreads();
}
__device__ __forceinline__ void fft_unit(KP P, int unit, LAS unsigned char* lds) {
    const int tid = opq_v(threadIdx.x), lane = tid & 63, wave = __builtin_amdgcn_readfirstlane(tid >> 6), fr = lane & 15, fq = lane >> 4;
    unsigned char* ws = P->ws;
    const int b = unit & 7, cblk = unit >> 3;
    const LAS float* lut = (const LAS float*)(lds + FFT_LUT_OFF);
    const LAS f32x2* tw = (const LAS f32x2*)(lds + FFT_TW_OFF);
    h16x8 W3[2][2];
#pragma unroll
    for (int mt3 = 0; mt3 < 2; ++mt3)
#pragma unroll
        for (int st = 0; st < 2; ++st)
#pragma unroll
            for (int e = 0; e < 8; ++e) { const int a = ((16 * mt3 + fr) * (16 * st + 4 * fq + (e & 3))) & 31; W3[mt3][st][e] = (h16)((e >> 2) ? lut[(2 * a - 16) & 63] : lut[2 * a]); }
    f32x4 D3[2][2][4];
#pragma unroll
    for (int chi = 0; chi < 2; ++chi) {
        const h16* xt = (const h16*)(ws + WS_REG + (size_t)b * REG_B) + (size_t)(2 * (16 * cblk + 2 * wave + chi)) * 2048;
        h16x8 A[2][4];
#pragma unroll
        for (int mt = 0; mt < 2; ++mt)
#pragma unroll
            for (int st = 0; st < 4; ++st) A[mt][st] = *(const h16x8*)(xt + (size_t)(st >> 1) * 2048 + (16 * mt + fr) * 64 + 32 * (st & 1) + 8 * fq);
        f32x4 D1[2][8];
#pragma unroll
        for (int nt = 0; nt < 8; ++nt) {
            h16x8 Bf[4];
#pragma unroll
            for (int st = 0; st < 4; ++st) Bf[st] = *(const LAS h16x8*)(lds + FFT_W1_OFF + (nt * 4 + st) * 1024 + lane * 16);
#pragma unroll
            for (int mt = 0; mt < 2; ++mt) {
                f32x4 d = (f32x4){0.f, 0.f, 0.f, 0.f};
#pragma unroll
                for (int st = 0; st < 4; ++st) d = MFMA16(A[mt][st], Bf[st], d);
                D1[mt][nt] = d;
            }
        }
#pragma unroll
        for (int mt3 = 0; mt3 < 2; ++mt3)
#pragma unroll
            for (int ntp = 0; ntp < 4; ++ntp) D3[chi][mt3][ntp] = (f32x4){0.f, 0.f, 0.f, 0.f};
#pragma unroll
        for (int mt = 0; mt < 2; ++mt)
#pragma unroll
            for (int ntp = 0; ntp < 4; ++ntp) {
                float vr[4], vi[4];
#pragma unroll
                for (int jj = 0; jj < 4; ++jj) {
                    const f32x2 t = tw[(16 * mt + 4 * fq + jj) * 64 + 16 * ntp + fr];
                    const float ur = D1[mt][ntp][jj], ui = D1[mt][ntp + 4][jj];
                    vr[jj] = ur * t.x + ui * t.y; vi[jj] = ui * t.x - ur * t.y;
                }
                u32x4 pk; pk.x = pkh(vr[0], vr[1]); pk.y = pkh(vr[2], vr[3]); pk.z = pkh(vi[0], vi[1]); pk.w = pkh(vi[2], vi[3]);
                const h16x8 vf = __builtin_bit_cast(h16x8, pk);
#pragma unroll
                for (int mt3 = 0; mt3 < 2; ++mt3) D3[chi][mt3][ntp] = MFMA16(W3[mt3][mt], vf, D3[chi][mt3][ntp]);
            }
    }
    LAS unsigned* stg = (LAS unsigned*)(lds + FFT_ST_OFF);
#pragma unroll
    for (int mt3 = 0; mt3 < 2; ++mt3)
#pragma unroll
        for (int ntp = 0; ntp < 4; ++ntp)
#pragma unroll
            for (int jj = 0; jj < 4; ++jj) { const int k1 = 16 * ntp + fr + 64 * (16 * mt3 + 4 * fq + jj); stg[k1 * 8 + wave] = pkh(D3[0][mt3][ntp][jj], D3[1][mt3][ntp][jj]); }
    __syncthreads();
    {
        const h16* zf = (const h16*)(ws + WS_REG + (size_t)b * REG_B + REG_PA);
        h16* Y = (h16*)(ws + WS_Y);
        const int hf = tid & 1;
        u32x4 zq[8];
#pragma unroll
        for (int i = 0; i < 8; ++i) zq[i] = *(const u32x4*)(zf + (size_t)((tid >> 1) + 256 * i) * 512 + 16 * cblk + 8 * hf);
#pragma unroll
        for (int i = 0; i < 8; ++i) {
            const int k1 = (tid >> 1) + 256 * i;
            const size_t tok = (size_t)b * S + k1;
            const u32x4 sv = *(const LAS u32x4*)(lds + FFT_ST_OFF + k1 * 32 + hf * 16);
            const u32x4 zv = zq[i];
            const f32x2 s0 = unpkh(sv.x), s1 = unpkh(sv.y), s2 = unpkh(sv.z), s3 = unpkh(sv.w);
            f32x2 z0 = unpkh(zv.x), z1 = unpkh(zv.y), z2 = unpkh(zv.z), z3 = unpkh(zv.w);
            { const f32x4 za = (f32x4){z0.x, z0.y, z1.x, z1.y}, zb = (f32x4){z2.x, z2.y, z3.x, z3.y}; const f32x4 ga = za * sigmoid4(za), gb = zb * sigmoid4(zb);
              z0 = (f32x2){ga[0], ga[1]}; z1 = (f32x2){ga[2], ga[3]}; z2 = (f32x2){gb[0], gb[1]}; z3 = (f32x2){gb[2], gb[3]}; }
            const float k = 1.f / 512.f;
            u32x4 o; o.x = pkh(s0.x * z0.x * k, s0.y * z0.y * k); o.y = pkh(s1.x * z1.x * k, s1.y * z1.y * k); o.z = pkh(s2.x * z2.x * k, s2.y * z2.y * k); o.w = pkh(s3.x * z3.x * k, s3.y * z3.y * k);
            *(u32x4*)(Y + tok * 1536 + 16 * cblk + 8 * hf) = o;
        }
    }
    __syncthreads();
}

__device__ __forceinline__ void conv_unit(KP P, int layer, int unit, LAS unsigned char* lds) {
    const int tid = opq_v(threadIdx.x), lane = tid & 63, wave = __builtin_amdgcn_readfirstlane(tid >> 6); unsigned char* ws = P->ws;
    const int t0 = unit * 64, b = t0 >> 11, s0 = t0 & 2047;
    const h16* cg = (const h16*)(ws + WS_REG + (size_t)b * REG_B + REG_PA + 1 * PA_STEP);
    const h16* zc = (const h16*)(ws + WS_REG + (size_t)b * REG_B + REG_PA + 2 * PA_STEP);
    h16* Y = (h16*)(ws + WS_Y);
    LAS unsigned char* tile = lds;
    LAS h16* O = (LAS h16*)(lds + CONV_O_OFF);
    const int p2 = tid & 255, th = tid >> 8;
    f32x2 w[32];
    {
        const float* cw = P->conv_c_w + (size_t)layer * CK * BW + 2 * p2;
#pragma unroll
        for (int j = 0; j < 31; ++j) w[j] = *(const f32x2*)(cw + j * BW);
        w[31] = (f32x2){0.f, 0.f};
    }
    const f32x2 bias = *(const f32x2*)(P->conv_c_b + layer * BW + 2 * p2);
    __syncthreads();
    {
        u32x4 tv[12];
#pragma unroll
        for (int j = 0; j < 12; ++j) {
            const int q = tid + j * NTHREADS, i = q >> 6, ck = q & 63, sq = s0 - 15 + i;
            tv[j] = (u32x4){0u, 0u, 0u, 0u};
            if (i < 94 && sq >= 0 && sq < S) tv[j] = *(const u32x4*)(cg + (size_t)sq * 512 + ck * 8);
        }
#pragma unroll
        for (int j = 0; j < 12; ++j) { const int q = tid + j * NTHREADS, i = q >> 6, ck = q & 63; if (i < CONV_ROWS) *(LAS u32x4*)(tile + i * 1024 + ck * 16) = tv[j]; }
    }
    u32x4 zr[8];
#pragma unroll
    for (int i = 0; i < 8; ++i) zr[i] = *(const u32x4*)(zc + (size_t)(s0 + 8 * wave + i) * 512 + 8 * lane);
    __syncthreads();
    {
        f32x2 win[32];
        const LAS unsigned* tp = (const LAS unsigned*)tile + (32 * th) * 256 + p2;
#pragma unroll
        for (int j = 0; j < 31; ++j) win[j] = unpkh(tp[j * 256]);
        win[31] = (f32x2){0.f, 0.f};
        LAS unsigned* Op = (LAS unsigned*)O + (32 * th) * 256 + p2;
#pragma unroll
        for (int tt = 0; tt < 32; ++tt) {
            win[(tt + 31) & 31] = unpkh(tp[(tt + 31) * 256]);
            f32x2 o0 = bias, o1 = (f32x2){0.f, 0.f};
#pragma unroll
            for (int j = 0; j < 32; j += 2) { o0 += w[j] * win[(tt + j) & 31]; o1 += w[j + 1] * win[(tt + j + 1) & 31]; }
            o0 += o1;
            Op[tt * 256] = pkh(o0.x, o0.y);
        }
    }
    __syncthreads();
    {
        const float* lg = P->ln_c_g + layer * BW + 8 * lane; const float* lb = P->ln_c_b + layer * BW + 8 * lane;
        float g8[8], b8[8];
#pragma unroll
        for (int e = 0; e < 8; ++e) { g8[e] = lg[e]; b8[e] = lb[e]; }
        float v[8][8], sm[8];
#pragma unroll
        for (int i = 0; i < 8; ++i) {
            const u32x4 ov = *(const LAS u32x4*)(O + (8 * wave + i) * 512 + 8 * lane);
            const f32x2 a0 = unpkh(ov.x), a1 = unpkh(ov.y), a2 = unpkh(ov.z), a3 = unpkh(ov.w);
            v[i][0] = a0.x; v[i][1] = a0.y; v[i][2] = a1.x; v[i][3] = a1.y; v[i][4] = a2.x; v[i][5] = a2.y; v[i][6] = a3.x; v[i][7] = a3.y;
            sm[i] = ((v[i][0] + v[i][1]) + (v[i][2] + v[i][3])) + ((v[i][4] + v[i][5]) + (v[i][6] + v[i][7]));
        }
#pragma unroll
        for (int st = 0; st < 4; ++st)
#pragma unroll
            for (int i = 0; i < 8; ++i) sm[i] = dpp_add(sm[i], st);
#pragma unroll
        for (int o = 16; o < 64; o <<= 1)
#pragma unroll
            for (int i = 0; i < 8; ++i) sm[i] += __shfl_xor(sm[i], o);
#pragma unroll
        for (int i = 0; i < 8; ++i) {
            const float mu = sm[i] * (1.f / BW); float q = 0.f;
#pragma unroll
            for (int e = 0; e < 8; ++e) { v[i][e] -= mu; q += v[i][e] * v[i][e]; }
            sm[i] = q;
        }
#pragma unroll
        for (int st = 0; st < 4; ++st)
#pragma unroll
            for (int i = 0; i < 8; ++i) sm[i] = dpp_add(sm[i], st);
#pragma unroll
        for (int o = 16; o < 64; o <<= 1)
#pragma unroll
            for (int i = 0; i < 8; ++i) sm[i] += __shfl_xor(sm[i], o);
#pragma unroll
        for (int i = 0; i < 8; ++i) {
            const float rstd = rsqrtf(sm[i] * (1.f / BW) + EPS);
            const size_t tok = (size_t)t0 + 8 * wave + i;
            const u32x4 zv = zr[i];
            float z[8]; { const f32x2 a0 = unpkh(zv.x), a1 = unpkh(zv.y), a2 = unpkh(zv.z), a3 = unpkh(zv.w); z[0] = a0.x; z[1] = a0.y; z[2] = a1.x; z[3] = a1.y; z[4] = a2.x; z[5] = a2.y; z[6] = a3.x; z[7] = a3.y; }
            f32x4 l0, l1;
#pragma unroll
            for (int e = 0; e < 4; ++e) { l0[e] = v[i][e] * rstd * g8[e] + b8[e]; l1[e] = v[i][4 + e] * rstd * g8[4 + e] + b8[4 + e]; }
            const f32x4 z0 = (f32x4){z[0], z[1], z[2], z[3]}, z1 = (f32x4){z[4], z[5], z[6], z[7]};
            const f32x4 o0 = (l0 * z0) * silu2den_rcp(l0, z0), o1 = (l1 * z1) * silu2den_rcp(l1, z1);
            u32x4 wv; wv.x = pkh(o0[0], o0[1]); wv.y = pkh(o0[2], o0[3]); wv.z = pkh(o1[0], o1[1]); wv.w = pkh(o1[2], o1[3]);
            *(u32x4*)(Y + tok * 1536 + 512 + 8 * lane) = wv;
        }
    }
    __syncthreads();
}
__device__ __forceinline__ void short_chunk(KP P, int layer, int chunk, int lane_) {
    const int lane = opq_v(lane_); unsigned char* ws = P->ws;
    const int t0 = chunk * 8, s0 = t0 & 2047, b = t0 >> 11;
    const h16* u = (const h16*)(ws + WS_REG + (size_t)b * REG_B + REG_PA + 3 * PA_STEP) + 8 * lane;
    const h16* vv = (const h16*)(ws + WS_REG + (size_t)b * REG_B + REG_PA + 4 * PA_STEP) + 8 * lane;
    h16* Y = (h16*)(ws + WS_Y) + 1024 + 8 * lane;
    u32x4 ur[10], vr[8];
#pragma unroll
    for (int i = 0; i < 10; ++i) { const int sq = s0 - 1 + i; ur[i] = (sq >= 0 && sq < S) ? *(const u32x4*)(u + (size_t)sq * 512) : (u32x4){0u, 0u, 0u, 0u}; }
#pragma unroll
    for (int i = 0; i < 8; ++i) vr[i] = *(const u32x4*)(vv + (size_t)(s0 + i) * 512);
    const float* sw = P->conv_s_w + (size_t)layer * 3 * BW + 8 * lane; const float* sb = P->conv_s_b + layer * BW + 8 * lane;
    float w0[8], w1[8], w2[8], bb[8];
#pragma unroll
    for (int e = 0; e < 8; ++e) { w0[e] = sw[e]; w1[e] = sw[BW + e]; w2[e] = sw[2 * BW + e]; bb[e] = sb[e]; }
#pragma unroll
    for (int i = 0; i < 8; ++i) {
        u32x4 wv;
#pragma unroll
        for (int q = 0; q < 4; ++q) {
            const f32x2 a = unpkh(ur[i][q]), b = unpkh(ur[i + 1][q]), c = unpkh(ur[i + 2][q]), v = unpkh(vr[i][q]);
            wv[q] = pkh(v.x * (w0[2 * q] * a.x + w1[2 * q] * b.x + w2[2 * q] * c.x + bb[2 * q]), v.y * (w0[2 * q + 1] * a.y + w1[2 * q + 1] * b.y + w2[2 * q + 1] * c.y + bb[2 * q + 1]));
        }
        *(u32x4*)(Y + (size_t)(t0 + i) * 1536) = wv;
    }
}
__device__ __forceinline__ void final_norm(KP P, int c, int G) {
    const int tid = opq_v(threadIdx.x), lane = tid & 63, wave = tid >> 6; unsigned char* ws = P->ws;
    const float* ss2 = (const float*)(ws + WS_CTL + CTL_SS) + 2 * (size_t)T;
    f32x4 g[4];
#pragma unroll
    for (int j = 0; j < 4; ++j) g[j] = ((const f32x4*)P->final_g)[lane + 64 * j];
    for (int row = c * NWAVES + wave; row < T; row += G * NWAVES) {
        const float rs = rsqrtf(ss2[row] * (1.f / D) + EPS);
        f32x4* xr = (f32x4*)(P->out + (size_t)row * D) + lane;
#pragma unroll
        for (int j = 0; j < 4; ++j) { f32x4 v = xr[64 * j]; xr[64 * j] = v * rs * g[j]; }
    }
}

__global__ void __launch_bounds__(NTHREADS, 2) mega_fwd(Args Pv) {
    extern __shared__ __attribute__((aligned(16))) unsigned char lds_raw[];
    LAS unsigned char* lds = (LAS unsigned char*)lds_raw;
    volatile LAS unsigned* MISC = (volatile LAS unsigned*)(lds + MISC_OFF);
    const int tid = threadIdx.x, lane = tid & 63, wave = __builtin_amdgcn_readfirstlane(tid >> 6);
    const int Gb = gridDim.x, cb = blockIdx.x;
    if (tid < 64) MISC[tid] = 0u;
    __syncthreads();
    XcdBarrier bar = xcd_barrier_post((unsigned*)(Pv.ws + WS_CTL + CTL_BAR), MISC + 8);
    const int lo = Pv.ph_lo, hi = Pv.ph_hi;
    for (int ph = lo; ph < hi; ++ph) {
#ifdef REP_KIND
        const int nrep = ((ph == 0 && REP_KIND == 4) || (ph >= 1 && ph <= 8 && ((ph - 1) & 3) == REP_KIND)) ? 2 : 1;
#else
        const int nrep = 1;
#endif
        for (int rep = 0; rep < nrep; ++rep) {
        const int G = opq_s(Gb), c = opq_s(cb);
        if (ph == 0) p0_prologue(kargs(), lds, c, G);
        else {
            const int l = (ph - 1) >> 2, k = (ph - 1) & 3;
            if (k == 1) {
                const int first = ((c >> 3) & 1) ? 1 : 0;
                for (int step = 0; step < 2; ++step) {
                    if ((step ^ first) == 0) { if (c < 256) fft_load_tables(kargs(), lds); for (int u = c; u < 256; u += G) fft_unit(kargs(), u, lds); }
                    else { for (int u = c; u < T / 64; u += G) { const int ub = (u & 7) * 32 + (u >> 3);
                               conv_unit(kargs(), l, ub, lds); short_chunk(kargs(), l, ub * NWAVES + wave, lane); } }
                }
                if (l + 1 < DEPTH) p0_weights(kargs(), lds, c, G, l + 1);
            } else {
                const bool split = (k == 2) && (G == 256) && (MISC[11] == 1u);
                Sched sc{k, l, G, c, split ? (unsigned*)(kargs()->ws + WS_CTL + CTL_GBAR) + 4096 * (c & 7) : nullptr}; gemm_phase(lds, sc, kargs()); }
        }
        if (ph + 1 < hi || rep + 1 < nrep) {
            unsigned* gbar = (unsigned*)(kargs()->ws + WS_CTL + CTL_GBAR) + 4096 * (c & 7);
            unsigned* prep = (unsigned*)(kargs()->ws + WS_CTL + CTL_PREP);
            const bool grp = (G == 256) && ph > 0;
            if (!grp) {
                xcd_barrier(bar);
                if (ph == 0 && G == 256 && tid == 0) (void)xb_add(&gbar[XB_XCNT(bar.x)], 1u);
            } else {
                XcdBarrier gb; gb.bar = gbar; gb.x = bar.x; gb.st = MISC + 10; gb.G = 32u;
                if (((ph - 1) & 3) == 1 && MISC[11] == 1u) {
                    asm volatile("s_waitcnt vmcnt(0)" ::: "memory");
                    __syncthreads();
                    if (tid == 0) (void)xb_add(&gbar[XB_ARR((ph - 1) >> 2)], 1u);
                } else xcd_barrier(gb, true);
                if (ph == 2 && tid == 0) (void)xb_add(prep, 1u);
                if (ph == 4) {
                    if (tid == 0) { XB_SPIN(xb_ld(prep) < 256u, gbar); __builtin_amdgcn_fence(__ATOMIC_ACQUIRE, "agent"); }
                    __syncthreads();
                }
            }
        }
        }
    }
}
}

extern "C" void kernel_launch(void* const* d_in, const int* in_sizes, int n_in, void* d_out, int out_size, void* d_ws, size_t ws_size, hipStream_t stream) {
    static int grid = 0;
    if (grid == 0) {
        int dev = 0, cus = 0, per_cu = 0;
        if (n_in != 13 || out_size != T * D || ws_size < WS_END) { fprintf(stderr, "kernel_launch: unexpected problem shape (n_in %d, out %d, ws %zu)\n", n_in, out_size, ws_size); grid = -1; return; }
        if (hipGetDevice(&dev) != hipSuccess || hipDeviceGetAttribute(&cus, hipDeviceAttributeMultiprocessorCount, dev) != hipSuccess) { grid = -1; return; }
        if (hipFuncSetAttribute((const void*)mega_fwd, hipFuncAttributeMaxDynamicSharedMemorySize, LDS_BYTES) != hipSuccess) { fprintf(stderr, "kernel_launch: hipFuncSetAttribute failed\n"); grid = -1; return; }
        if (hipOccupancyMaxActiveBlocksPerMultiprocessor(&per_cu, (const void*)mega_fwd, NTHREADS, LDS_BYTES) != hipSuccess || per_cu < 1) { fprintf(stderr, "kernel_launch: occupancy query says %d blocks per CU\n", per_cu); per_cu = 1; }
        (void)hipGetLastError();
        grid = cus;
        if (grid > 256) grid = 256;
        grid &= ~7;
    }
    if (grid <= 0) return;
    (void)hipMemsetAsync((char*)d_ws + WS_CTL + CTL_BAR, 0, XCD_BAR_WORDS * 4, stream);
    Args a{};
    a.x = (const float*)d_in[0]; a.norm_g = (const float*)d_in[1]; a.w_in = (const float*)d_in[2]; a.b_in = (const float*)d_in[3]; a.conv_c_w = (const float*)d_in[4]; a.conv_c_b = (const float*)d_in[5];
    a.ln_c_g = (const float*)d_in[6]; a.ln_c_b = (const float*)d_in[7]; a.conv_s_w = (const float*)d_in[8]; a.conv_s_b = (const float*)d_in[9]; a.w_branch = (const float*)d_in[10]; a.w_out = (const float*)d_in[11];
    a.final_g = (const float*)d_in[12]; a.out = (float*)d_out; a.ws = (unsigned char*)d_ws;
#if MK_N_LAUNCHES == 1
    a.ph_lo = 0; a.ph_hi = 9;
    hipLaunchKernelGGL(mega_fwd, dim3(grid), dim3(NTHREADS), LDS_BYTES, stream, a);
#else
    for (int p = 0; p < 9; ++p) { a.ph_lo = p; a.ph_hi = p + 1; hipLaunchKernelGGL(mega_fwd, dim3(grid), dim3(NTHREADS), LDS_BYTES, stream, a); }
#endif
}
```

```cpp
#include <hip/hip_runtime.h>
#include <cstdint>
#include <cstdio>

#ifndef MK_N_LAUNCHES
#define MK_N_LAUNCHES 1
#endif

namespace {
#define LAS __attribute__((address_space(3)))
#ifndef USE_BF16
#define USE_BF16 1
#endif
#if USE_BF16
typedef __bf16 h16;
typedef __bf16 h16x8 __attribute__((ext_vector_type(8)));
typedef __bf16 h16x2 __attribute__((ext_vector_type(2)));
#define MFMA16(a, b, c) __builtin_amdgcn_mfma_f32_16x16x32_bf16(a, b, c, 0, 0, 0)
#else
typedef _Float16 h16;
typedef _Float16 h16x8 __attribute__((ext_vector_type(8)));
typedef _Float16 h16x2 __attribute__((ext_vector_type(2)));
#define MFMA16(a, b, c) __builtin_amdgcn_mfma_f32_16x16x32_f16(a, b, c, 0, 0, 0)
#endif
typedef float f32x4 __attribute__((ext_vector_type(4)));
typedef float f32x2 __attribute__((ext_vector_type(2)));
typedef unsigned u32x4 __attribute__((ext_vector_type(4)));
typedef unsigned u32x2 __attribute__((ext_vector_type(2)));

constexpr int D = 1024, NB = 8, S = 2048, T = NB * S, DEPTH = 2, BW = 512, INW = 7680, CK = 31;
constexpr float EPS = 1e-6f;
constexpr int NP = 8192;
constexpr int NTHREADS = 512, NWAVES = 8;

constexpr size_t MiB = 1u << 20;
constexpr size_t WS_CTL = 0, CTL_BYTES = 1 * MiB;
constexpr size_t CTL_BAR = 16384;
constexpr size_t CTL_SS = 128 * 1024;
constexpr size_t CTL_DUMMY = 64 * 1024;
constexpr size_t CTL_BIAS = 512 * 1024;
constexpr size_t CTL_XS = 576 * 1024;
constexpr size_t CTL_XCNT = 832 * 1024;
constexpr size_t CTL_GBAR = 320 * 1024;
constexpr size_t CTL_PREP = 448 * 1024;
constexpr size_t WS_WB = 1 * MiB;
constexpr size_t WS_WO = 7 * MiB;
constexpr size_t WS_WI = 11 * MiB;
constexpr size_t WS_XB = 43 * MiB;
constexpr size_t WS_Y = 75 * MiB;
constexpr size_t WS_REG = 123 * MiB, REG_B = 16 * MiB;
constexpr size_t REG_PA = 4 * MiB, PA_STEP = 2 * MiB, REG_M = 12 * MiB;
__device__ __forceinline__ unsigned gs_native(int pm, int pn, int k, int rl0, int cl0) {
    return (unsigned)((((pm & 7) * 4 + pn) * 3 + k) * 65536 + ((rl0 >> 6) * 4 + (cl0 >> 5)) * 1024 + (((cl0 >> 3) & 3) * 16 + (rl0 & 15)) * 16);
}
constexpr size_t WS_TAB = 251 * MiB;
constexpr size_t WS_END = 252 * MiB;

constexpr int LDS_BYTES = 163840;
constexpr int MISC_OFF = 163840 - 256;
constexpr int CONV_ROWS = 95, CONV_TILE_BYTES = CONV_ROWS * 1024, CONV_O_OFF = CONV_TILE_BYTES, CONV_O_BYTES = 64 * 1024;
static_assert(CONV_O_OFF + CONV_O_BYTES <= MISC_OFF, "lds map");
constexpr int EPI_SS_OFF = 139264, EPI_BIAS_OFF = EPI_SS_OFF + 1024;

__device__ __forceinline__ unsigned pkh(float a, float b) { h16x2 h = __builtin_convertvector((f32x2){a, b}, h16x2); return __builtin_bit_cast(unsigned, h); }
#ifndef WBITS
#define WBITS 1
#endif
__device__ __forceinline__ unsigned rw(float f) { unsigned u = __builtin_bit_cast(unsigned, f); u += ((1u << (15 + WBITS)) - 1u) + ((u >> (16 + WBITS)) & 1u); return u & (0xFFFFFFFFu << (16 + WBITS)); }
__device__ __forceinline__ unsigned pkw(float a, float b) { return (rw(a) >> 16) | rw(b); }
__device__ __forceinline__ f32x2 unpkh(unsigned u) { h16x2 h = __builtin_bit_cast(h16x2, u); return __builtin_convertvector(h, f32x2); }
__device__ __forceinline__ float sigmoid_f(float x) { return __builtin_amdgcn_rcpf(1.f + __expf(-x)); }
__device__ __forceinline__ f32x4 sigden4(f32x4 v) {
    const f32x4 t = v * -1.4426950408889634f;
    f32x4 e; e[0] = __builtin_amdgcn_exp2f(t[0]); e[1] = __builtin_amdgcn_exp2f(t[1]); e[2] = __builtin_amdgcn_exp2f(t[2]); e[3] = __builtin_amdgcn_exp2f(t[3]);
    return __builtin_elementwise_min(e + 1.0f, (f32x4){16129.f, 16129.f, 16129.f, 16129.f});
}
__device__ __forceinline__ unsigned gate_q4(f32x4 v) {
    const f32x4 t = v * -1.4426950408889634f;
    f32x4 e; e[0] = __builtin_amdgcn_exp2f(t[0]); e[1] = __builtin_amdgcn_exp2f(t[1]); e[2] = __builtin_amdgcn_exp2f(t[2]); e[3] = __builtin_amdgcn_exp2f(t[3]);
    const f32x4 d = (e + 1.0f) * (1.f / 256.f);
    unsigned q = 0u;
    q = __builtin_amdgcn_cvt_pk_u8_f32(__builtin_fmaxf(__builtin_amdgcn_rcpf(d[0]), 1.f), 0u, q); q = __builtin_amdgcn_cvt_pk_u8_f32(__builtin_fmaxf(__builtin_amdgcn_rcpf(d[1]), 1.f), 1u, q);
    q = __builtin_amdgcn_cvt_pk_u8_f32(__builtin_fmaxf(__builtin_amdgcn_rcpf(d[2]), 1.f), 2u, q); q = __builtin_amdgcn_cvt_pk_u8_f32(__builtin_fmaxf(__builtin_amdgcn_rcpf(d[3]), 1.f), 3u, q);
    return q;
}
__device__ __forceinline__ f32x4 gate_u4(unsigned q) { return (f32x4){(float)(q & 255u), (float)((q >> 8) & 255u), (float)((q >> 16) & 255u), (float)(q >> 24)}; }
__device__ __forceinline__ f32x4 rcp4(f32x4 v) { return (f32x4){__builtin_amdgcn_rcpf(v[0]), __builtin_amdgcn_rcpf(v[1]), __builtin_amdgcn_rcpf(v[2]), __builtin_amdgcn_rcpf(v[3])}; }
__device__ __forceinline__ f32x4 sigmoid4(f32x4 v) {
    const f32x4 t = v * -1.4426950408889634f;
    f32x4 e; e[0] = __builtin_amdgcn_exp2f(t[0]); e[1] = __builtin_amdgcn_exp2f(t[1]); e[2] = __builtin_amdgcn_exp2f(t[2]); e[3] = __builtin_amdgcn_exp2f(t[3]);
    const f32x4 d = e + 1.0f;
    f32x4 r; r[0] = __builtin_amdgcn_rcpf(d[0]); r[1] = __builtin_amdgcn_rcpf(d[1]); r[2] = __builtin_amdgcn_rcpf(d[2]); r[3] = __builtin_amdgcn_rcpf(d[3]);
    return r;
}
__device__ __forceinline__ f32x4 silu2den_rcp(f32x4 a, f32x4 b) {
    const f32x4 ta = a * -1.4426950408889634f, tb = b * -1.4426950408889634f;
    f32x4 ea, eb;
    ea[0] = __builtin_amdgcn_exp2f(ta[0]); ea[1] = __builtin_amdgcn_exp2f(ta[1]); ea[2] = __builtin_amdgcn_exp2f(ta[2]); ea[3] = __builtin_amdgcn_exp2f(ta[3]);
    eb[0] = __builtin_amdgcn_exp2f(tb[0]); eb[1] = __builtin_amdgcn_exp2f(tb[1]); eb[2] = __builtin_amdgcn_exp2f(tb[2]); eb[3] = __builtin_amdgcn_exp2f(tb[3]);
    const f32x4 d = (ea + 1.0f) * (eb + 1.0f);
    f32x4 r; r[0] = __builtin_amdgcn_rcpf(d[0]); r[1] = __builtin_amdgcn_rcpf(d[1]); r[2] = __builtin_amdgcn_rcpf(d[2]); r[3] = __builtin_amdgcn_rcpf(d[3]);
    return r;
}
__device__ __forceinline__ float dpp_add(float v, const int ctrl_is  ) {
    const int x = __builtin_bit_cast(int, v);
    int y;
    if (ctrl_is == 0) y = __builtin_amdgcn_update_dpp(x, x, 0xB1, 0xF, 0xF, false);
    else if (ctrl_is == 1) y = __builtin_amdgcn_update_dpp(x, x, 0x4E, 0xF, 0xF, false);
    else if (ctrl_is == 2) y = __builtin_amdgcn_update_dpp(x, x, 0x141, 0xF, 0xF, false);
    else y = __builtin_amdgcn_update_dpp(x, x, 0x140, 0xF, 0xF, false);
    return v + __builtin_bit_cast(float, y);
}
__device__ __forceinline__ float wave_sum_dpp(float v) {
    v = dpp_add(v, 0); v = dpp_add(v, 1); v = dpp_add(v, 2); v = dpp_add(v, 3);
    v += __shfl_xor(v, 16); v += __shfl_xor(v, 32);
    return v;
}
__device__ __forceinline__ float wave_sum(float v) {
#pragma unroll
    for (int o = 1; o < 64; o <<= 1) v += __shfl_xor(v, o);
    return v;
}
#define LDS_WAIT() asm volatile("s_waitcnt lgkmcnt(0)" ::: "memory")
__device__ __forceinline__ void st16_wt(void* base, unsigned byte_off, u32x4 v) {
    __builtin_amdgcn_raw_buffer_store_b128(v, __builtin_amdgcn_make_buffer_rsrc(base, 0, 0x7fffffff, 0x00020000), byte_off, 0, 16);
}
__device__ __forceinline__ void st8_wt(void* base, unsigned byte_off, u32x2 v) {
    __builtin_amdgcn_raw_buffer_store_b64(v, __builtin_amdgcn_make_buffer_rsrc(base, 0, 0x7fffffff, 0x00020000), byte_off, 0, 16);
}
__device__ __forceinline__ unsigned char* opq(unsigned char* p) { asm volatile("" : "+s"(p)); return p; }
__device__ __forceinline__ int opq_v(int v) { asm volatile("" : "+v"(v)); return v; }
__device__ __forceinline__ int opq_s(int v) { asm volatile("" : "+s"(v)); return v; }

#define XB_TMO      128
#define XB_XCNT(j)  (256  + 64 * (j))
#define XB_XSUB(j)  (1280 + 64 * (j))
#define XB_XGEN(j)  (2304 + 64 * (j))
#define XB_TOP      3328
#define XB_TOPGEN   3392
#define XCD_BAR_WORDS 3456
#define XB_SPIN_CAP (1u << 18)
__device__ __forceinline__ unsigned xb_ld(unsigned* p)              { return __hip_atomic_load(p, __ATOMIC_RELAXED, __HIP_MEMORY_SCOPE_AGENT); }
__device__ __forceinline__ unsigned xb_add(unsigned* p, unsigned v) { return __hip_atomic_fetch_add(p, v, __ATOMIC_RELAXED, __HIP_MEMORY_SCOPE_AGENT); }
__device__ __forceinline__ unsigned xb_xcc_id() { return (unsigned)__builtin_amdgcn_s_getreg((3 << 11) | 20) & 0xFu; }
#define XB_SPIN(cond, bar) do { unsigned _sp = 0; while (cond) { __builtin_amdgcn_s_sleep(1); \
    if ((++_sp & 255u) == 0u) { if (xb_ld(&(bar)[XB_TMO])) break; if (_sp > XB_SPIN_CAP) { atomicAdd(&(bar)[XB_TMO], 1u); break; } } } } while (0)
struct XcdBarrier { unsigned* bar; unsigned x; volatile LAS unsigned* st; unsigned G; };
__device__ __forceinline__ XcdBarrier xcd_barrier_post(unsigned* bar, volatile LAS unsigned* st) {
    XcdBarrier b; b.bar = bar; b.x = xb_xcc_id(); b.st = st; b.G = gridDim.x * gridDim.y * gridDim.z;
    if (threadIdx.x == 0) (void)xb_add(&bar[XB_XCNT(b.x)], 1u);
    return b;
}
__device__ __forceinline__ void xcd_barrier_complete(unsigned* bar, unsigned x, unsigned G, unsigned& nloc, unsigned& nx) {
    unsigned sum, cnt, mine, sp = 0u;
    for (;;) {
        sum = 0u; cnt = 0u; mine = 0u;
#pragma unroll
        for (unsigned j = 0; j < 16; ++j) { const unsigned c = xb_ld(&bar[XB_XCNT(j)]); sum += c; cnt += (c > 0u) ? 1u : 0u; mine = (j == x) ? c : mine; }
        if (sum == G) break;
        __builtin_amdgcn_s_sleep(1);
        if ((++sp & 255u) == 0u) { if (xb_ld(&bar[XB_TMO])) break; if (sp > XB_SPIN_CAP) { atomicAdd(&bar[XB_TMO], 1u); break; } }
    }
    nloc = mine > 0u ? mine : 1u; nx = cnt > 0u ? cnt : 1u;
}
__device__ __forceinline__ void xcd_barrier(const XcdBarrier& b, bool local_ok = false) {
    asm volatile("s_waitcnt vmcnt(0)" ::: "memory");
    __syncthreads();
    if (threadIdx.x == 0) {
        unsigned* bar = b.bar;
        __builtin_amdgcn_s_waitcnt(0);
        unsigned nloc = b.st[0], nx = b.st[1];
        if (nloc == 0u) { xcd_barrier_complete(bar, b.x, b.G, nloc, nx); b.st[0] = nloc; b.st[1] = nx; }
        if (local_ok && nx == 1u) {
            asm volatile("buffer_inv sc1" ::: "memory");
            const unsigned old = xb_add(&bar[XB_XSUB(b.x)], 1u);
            const unsigned gen = old / nloc;
            if (old + 1u == (gen + 1u) * nloc) xb_add(&bar[XB_XGEN(b.x)], 1u);
            else XB_SPIN(xb_ld(&bar[XB_XGEN(b.x)]) == gen, bar);
            asm volatile("s_waitcnt vmcnt(0)" ::: "memory");
        } else {
        const unsigned old = xb_add(&bar[XB_XSUB(b.x)], 1u);
        const unsigned gen = old / nloc;
        if (old + 1u == (gen + 1u) * nloc) {
            __builtin_amdgcn_fence(__ATOMIC_RELEASE, "agent");
            asm volatile("s_waitcnt vmcnt(0)" ::: "memory");
            const unsigned og = xb_add(&bar[XB_TOP], 1u);
            const unsigned tg = og / nx;
            if (og + 1u == (tg + 1u) * nx) xb_add(&bar[XB_TOPGEN], 1u);
            else XB_SPIN(xb_ld(&bar[XB_TOPGEN]) == tg, bar);
            __builtin_amdgcn_fence(__ATOMIC_ACQUIRE, "agent");
            xb_add(&bar[XB_XGEN(b.x)], 1u);
            asm volatile("s_waitcnt vmcnt(0)" ::: "memory");
        } else {
            XB_SPIN(xb_ld(&bar[XB_XGEN(b.x)]) == gen, bar);
            __builtin_amdgcn_fence(__ATOMIC_ACQUIRE, "agent");
            asm volatile("s_waitcnt vmcnt(0)" ::: "memory");
        }
        }
    }
    __syncthreads();
}

struct Args {
    const float* x; const float* norm_g; const float* w_in; const float* b_in; const float* conv_c_w; const float* conv_c_b; const float* ln_c_g; const float* ln_c_b;
    const float* conv_s_w; const float* conv_s_b; const float* w_branch; const float* w_out; const float* final_g;
    float* out; unsigned char* ws; int ph_lo, ph_hi;
};
typedef const __attribute__((address_space(4))) Args* KP;
__device__ __forceinline__ KP kargs() { KP p = (KP)__builtin_amdgcn_kernarg_segment_ptr(); asm volatile("" : "+s"(p)); return p; }

constexpr int BM = 256, BK = 64, HALF = 128, HTB = HALF * BK * 2, KSTEP = BK * 2;
__device__ __forceinline__ int lds_byte(int r, int c) { const int st = (r >> 4) * 2 + (c >> 5), rr = r & 15, cc = c & 31, ob = rr * 64 + cc * 2; return st * 1024 + (ob ^ (((ob >> 9) & 1) << 5)); }
__device__ __forceinline__ void stage_rc(int b, int& R, int& C) { const int st = b / 1024, sb = b % 1024, swz = sb ^ (((sb >> 9) & 1) << 5); R = (st >> 1) * 16 + swz / 64; C = (st & 1) * 32 + (swz % 64) / 2; }
__device__ __forceinline__ int perm32(int rho) { const int n = rho >> 4, i = rho & 15; return 8 * (i >> 2) + 4 * n + (i & 3); }

enum Mode { M_ACT = 0, M_GLU, M_MUL, M_MULSILU, M_X, M_GATE, M_YB, M_OUT };
enum Phase { PH_INPROJ = 0, PH_MIX = 2, PH_OUT = 3 };
struct Unit {
    const char* A; const char* B;
    int lda2, ldb2;
    int nt;
    int mode, pm, pn, aux;
    const float* ssp; const float* bip; int ssperm;
    int bperm;
};
#define XB_ARR(l)   (3408 + 16 * (l))
struct Sched {
    int phase, layer, G, c;
    unsigned* arr;
    __device__ __forceinline__ bool next(int i, Unit& u) const {
        const char* w = (const char*)kargs()->ws;
        if (phase == PH_INPROJ) {
            const int L = i * G + c; if (L >= 64 * 20) return false;
            const int xcd = L & 7, off = L >> 3;
            const int tm = 8 * xcd + (off & 7), tn = off >> 3;
            u.nt = 16; u.lda2 = 2048; u.ldb2 = 2048; u.bperm = 0;
            const float* ssl = (const float*)(w + WS_CTL + CTL_SS) + (size_t)layer * T; const float* bil = (const float*)(w + WS_CTL + CTL_BIAS) + (size_t)layer * NP;
            const char* xb = w + WS_XB + (size_t)tm * 256 * 2048;
            const char* wi = w + WS_WI + (size_t)layer * NP * 2048;
            if (tn < 16) {
                u.A = xb; u.B = wi + (size_t)(1024 + 256 * tn) * 2048; u.pm = tm; u.pn = tn;
                u.mode = (tn < 2) ? M_ACT : (tn < 6) ? M_GLU : (tn < 8) ? M_ACT : (tn < 12) ? M_MUL : M_MULSILU;
                u.aux = (tn < 2) ? tn : (tn < 6) ? tn - 2 : (tn < 8) ? tn - 6 : (tn < 12) ? tn - 8 : tn - 12;
                u.ssp = ssl + tm * 256; u.bip = bil + 1024 + 256 * tn; u.ssperm = 0;
            } else {
                u.A = wi + (size_t)(256 * (tn - 16)) * 2048; u.B = w + WS_XB + ((size_t)(tm >> 3) * 2048 + 4 * (tm & 7)) * 2048; u.pm = tn - 16; u.pn = tm; u.mode = M_X; u.aux = 0; u.bperm = 1;
                u.ssp = ssl + (size_t)(tm >> 3) * 2048 + 4 * (tm & 7); u.bip = bil + 256 * (tn - 16); u.ssperm = 1;
            }
            return true;
        } else {
            const int per = (phase == PH_MIX) ? 6 : 1;
            const int tl = c + (i / per) * G, sub = i % per; if (tl >= 256) return false;
            const int xcd = tl & 7, q = tl >> 3;
            u.pm = 8 * xcd + (q >> 2); u.pn = q & 3; u.bperm = 0; u.ssp = nullptr; u.bip = nullptr; u.ssperm = 0;
            if (phase == PH_OUT) {
                u.A = w + WS_REG + (size_t)(u.pm >> 3) * REG_B + REG_M + (size_t)(u.pm & 7) * 256 * 2048; u.B = w + WS_WO + ((size_t)layer * 1024 + 256 * u.pn) * 2048; u.lda2 = 2048; u.ldb2 = 2048; u.nt = 16; u.mode = M_OUT; u.aux = 0;
            } else if (sub < 3) {
                u.A = w + WS_XB + (size_t)u.pm * 256 * 2048; u.B = w + WS_WI + ((size_t)layer * NP + 5120 + 1024 * sub + 256 * u.pn) * 2048; u.lda2 = 2048; u.ldb2 = 2048; u.nt = 16; u.mode = M_GATE; u.aux = sub;
                u.ssp = (const float*)(w + WS_CTL + CTL_SS) + (size_t)layer * T + u.pm * 256; u.bip = (const float*)(w + WS_CTL + CTL_BIAS) + (size_t)layer * NP + 5120 + 1024 * sub + 256 * u.pn;
            } else {
                const int k = sub - 3;
                u.A = w + WS_Y + (size_t)u.pm * 256 * 3072 + k * 1024; u.B = w + WS_WB + (((size_t)layer * 3 + k) * 1024 + 256 * u.pn) * 1024; u.lda2 = 3072; u.ldb2 = 1024; u.nt = 8; u.mode = M_YB; u.aux = k;
            }
            return true;
        }
    }
};

template <int MODE> __device__ __forceinline__ void epi_tok(const f32x4 (&acc)[2][2][4][2], const Unit& u, unsigned char* ws, const LAS float* ssS, const LAS float* biasS, int rl0, int cl0) {
    f32x4 bv[2][2];
#pragma unroll
    for (int bj = 0; bj < 2; ++bj)
#pragma unroll
        for (int n = 0; n < 2; ++n) bv[bj][n] = *(const LAS f32x4*)(biasS + 128 * bj + cl0 + 4 * n);
    h16* dst; int ld, colbase;
    unsigned char* reg = ws + WS_REG + (size_t)(u.pm >> 3) * REG_B;
    if (MODE == M_GATE) { dst = (h16*)reg; ld = 3072; colbase = 1024 * u.aux + 256 * u.pn; }
    else if (MODE == M_ACT) { dst = (h16*)(reg + REG_PA + (u.pn < 2 ? 0 : 2) * PA_STEP); ld = 512; colbase = 256 * u.aux; }
    else { dst = (h16*)(reg + REG_PA + (MODE == M_GLU ? 1 : MODE == M_MUL ? 3 : 4) * PA_STEP); ld = 512; colbase = 128 * u.aux; }
    float rs[2][4];
#pragma unroll
    for (int ai = 0; ai < 2; ++ai)
#pragma unroll
        for (int m = 0; m < 4; ++m) rs[ai][m] = rsqrtf(ssS[128 * ai + 16 * m + rl0] * (1.f / D) + EPS);
#pragma unroll
    for (int ai = 0; ai < 2; ++ai)
#pragma unroll
        for (int m = 0; m < 4; ++m) {
            const int row = (u.pm & 7) * 256 + 128 * ai + 16 * m + rl0;
            const float r1 = rs[ai][m];
            h16* rowp = dst + (size_t)row * ld + colbase + cl0;
            const unsigned rowb = (unsigned)(row * ld + colbase + cl0) * 2u;
            if (MODE == M_GATE) {
                u32x4 wv;
                wv.x = gate_q4(acc[ai][0][m][0] * r1 + bv[0][0]); wv.y = gate_q4(acc[ai][0][m][1] * r1 + bv[0][1]); wv.z = gate_q4(acc[ai][1][m][0] * r1 + bv[1][0]); wv.w = gate_q4(acc[ai][1][m][1] * r1 + bv[1][1]);
                *(u32x4*)(reg + gs_native(u.pm, u.pn, u.aux, rl0, cl0) + 8192 * (ai * 4 + m)) = wv;
            } else if (MODE == M_ACT) {
#pragma unroll
                for (int bj = 0; bj < 2; ++bj) {
                    const f32x4 v0 = acc[ai][bj][m][0] * r1 + bv[bj][0], v1 = acc[ai][bj][m][1] * r1 + bv[bj][1];
                    u32x4 wv; wv.x = pkh(v0[0], v0[1]); wv.y = pkh(v0[2], v0[3]); wv.z = pkh(v1[0], v1[1]); wv.w = pkh(v1[2], v1[3]);
                    *(u32x4*)(rowp + 128 * bj) = wv;
                }
            } else {
                f32x4 o[2];
#pragma unroll
                for (int n = 0; n < 2; ++n) {
                    const f32x4 a = acc[ai][0][m][n] * r1 + bv[0][n], b = acc[ai][1][m][n] * r1 + bv[1][n];
                    if (MODE == M_GLU) o[n] = a * sigmoid4(b);
                    else if (MODE == M_MUL) o[n] = a * b;
                    else o[n] = a * b * sigmoid4(b);
                }
                u32x4 wv; wv.x = pkh(o[0][0], o[0][1]); wv.y = pkh(o[0][2], o[0][3]); wv.z = pkh(o[1][0], o[1][1]); wv.w = pkh(o[1][2], o[1][3]);
                *(u32x4*)rowp = wv;
            }
        }
}
__device__ __forceinline__ void epilogue(const f32x4 (&acc)[2][2][4][2], const Unit& u, KP P, LAS unsigned char* lds, int layer, int wr, int wc, int fr, int fq) {
    unsigned char* ws = P->ws;
    const LAS float* ssS = (const LAS float*)(lds + EPI_SS_OFF);
    const LAS float* biasS = (const LAS float*)(lds + EPI_BIAS_OFF);
    const int rl0 = opq_v(wr * 64 + fr);
    const int cl0 = opq_v(wc * 32 + 8 * fq);
    const int mode = u.mode;
    if (mode == M_ACT) { epi_tok<M_ACT>(acc, u, ws, ssS, biasS, rl0, cl0); return; }
    if (mode == M_GATE) { epi_tok<M_GATE>(acc, u, ws, ssS, biasS, rl0, cl0); return; }
    if (mode == M_GLU) { epi_tok<M_GLU>(acc, u, ws, ssS, biasS, rl0, cl0); return; }
    if (mode == M_MUL) { epi_tok<M_MUL>(acc, u, ws, ssS, biasS, rl0, cl0); return; }
    if (mode == M_MULSILU) { epi_tok<M_MULSILU>(acc, u, ws, ssS, biasS, rl0, cl0); return; }
    if (mode == M_X) {
        const int b = u.pn >> 3, pj = u.pn & 7, n10 = 256 * pj;
        f32x4 rc[2][2];
#pragma unroll
        for (int bj = 0; bj < 2; ++bj)
#pragma unroll
            for (int n = 0; n < 2; ++n) {
                const f32x4 s4 = *(const LAS f32x4*)(ssS + 128 * bj + cl0 + 4 * n);
#pragma unroll
                for (int e = 0; e < 4; ++e) rc[bj][n][e] = rsqrtf(s4[e] * (1.f / D) + EPS);
            }
        h16* xt = (h16*)(ws + WS_REG + (size_t)b * REG_B);
#pragma unroll
        for (int ai = 0; ai < 2; ++ai)
#pragma unroll
            for (int m = 0; m < 4; ++m) {
                const int wrow = u.pm * 256 + 128 * ai + 16 * m + rl0;
                const float bvr = biasS[128 * ai + 16 * m + rl0];
                const unsigned rowb = (unsigned)(wrow * 2048 + n10 + cl0) * 2u;
#pragma unroll
                for (int bj = 0; bj < 2; ++bj) {
                    const f32x4 v0 = acc[ai][bj][m][0] * rc[bj][0] + bvr, v1 = acc[ai][bj][m][1] * rc[bj][1] + bvr;
                    u32x4 wv; wv.x = pkh(v0[0], v0[1]); wv.y = pkh(v0[2], v0[3]); wv.z = pkh(v1[0], v1[1]); wv.w = pkh(v1[2], v1[3]);
                    *(u32x4*)((unsigned char*)xt + rowb + 256u * bj) = wv;
                }
                asm volatile("" ::: "memory");
            }
        return;
    }
    if (mode == M_YB) {
        if (u.aux < 2) return;
        unsigned char* reg = ws + WS_REG + (size_t)(u.pm >> 3) * REG_B;
        const unsigned char* g2 = reg + gs_native(u.pm, u.pn, 2, rl0, cl0);
        h16* Mo = (h16*)(reg + REG_M);
#pragma unroll
        for (int ai = 0; ai < 2; ++ai) {
            u32x4 gA[4];
#pragma unroll
            for (int m = 0; m < 4; ++m) gA[m] = *(const u32x4*)(g2 + 8192 * (ai * 4 + m));
            __builtin_amdgcn_sched_barrier(0);
#pragma unroll
            for (int m = 0; m < 4; ++m) {
                const size_t row = (size_t)(u.pm & 7) * 256 + 128 * ai + 16 * m + rl0;
                h16* gp = Mo + row * 1024 + 256 * u.pn + cl0;
#pragma unroll
                for (int bj = 0; bj < 2; ++bj) {
                    const f32x4 v0 = acc[ai][bj][m][0] * (gate_u4(gA[m][2 * bj]) * (1.f / 256.f)), v1 = acc[ai][bj][m][1] * (gate_u4(gA[m][2 * bj + 1]) * (1.f / 256.f));
                    u32x4 wv; wv.x = pkh(v0[0], v0[1]); wv.y = pkh(v0[2], v0[3]); wv.z = pkh(v1[0], v1[1]); wv.w = pkh(v1[2], v1[3]);
                    *(u32x4*)(gp + 128 * bj) = wv;
                }
                asm volatile("" ::: "memory");
            }
        }
        return;
    }
    {
        h16* xb = (h16*)(ws + WS_XB);
        float* ssn = (float*)(ws + WS_CTL + CTL_SS) + (size_t)(layer + 1) * T;
#pragma unroll
        for (int ai = 0; ai < 2; ++ai) {
            u32x4 rV[4][2];
#pragma unroll
            for (int m = 0; m < 4; ++m)
#pragma unroll
                for (int bj = 0; bj < 2; ++bj) rV[m][bj] = *(const u32x4*)(xb + ((size_t)u.pm * 256 + 128 * ai + 16 * m + rl0) * 1024 + 256 * u.pn + cl0 + 128 * bj);
            __builtin_amdgcn_sched_barrier(0);
#pragma unroll
            for (int m = 0; m < 4; ++m) {
                const size_t row = (size_t)u.pm * 256 + 128 * ai + 16 * m + rl0;
                const size_t off = row * 1024 + 256 * u.pn + cl0;
                float sq = 0.f;
#pragma unroll
                for (int bj = 0; bj < 2; ++bj) {
                    const u32x4 rv = rV[m][bj];
                    const f32x2 a0 = unpkh(rv.x), a1 = unpkh(rv.y), a2 = unpkh(rv.z), a3 = unpkh(rv.w);
                    const f32x4 v0 = (f32x4){a0.x, a0.y, a1.x, a1.y} + acc[ai][bj][m][0], v1 = (f32x4){a2.x, a2.y, a3.x, a3.y} + acc[ai][bj][m][1];
                    u32x4 wv; wv.x = pkh(v0[0], v0[1]); wv.y = pkh(v0[2], v0[3]); wv.z = pkh(v1[0], v1[1]); wv.w = pkh(v1[2], v1[3]);
                    *(u32x4*)(xb + off + 128 * bj) = wv;
                    sq += (v0[0] * v0[0] + v0[1] * v0[1]) + (v0[2] * v0[2] + v0[3] * v0[3]) + (v1[0] * v1[0] + v1[1] * v1[1]) + (v1[2] * v1[2] + v1[3] * v1[3]);
                }
                sq += __shfl_xor(sq, 16); sq += __shfl_xor(sq, 32);
                if (fq == 0) atomicAdd(ssn + row, sq);
                if (m == 3) asm volatile("" ::: "memory");
            }
        }
        return;
    }
}
constexpr int EX_P_OFF = 131072, EX_S_OFF = EX_P_OFF + 4096, EX_FLAG_OFF = EX_S_OFF + 1024;
__device__ __forceinline__ void epi_out_last(f32x4 (&acc)[2][2][4][2], const Unit& u, KP P, LAS unsigned char* lds, int wr, int wc, int fr, int fq) {
    unsigned char* ws = P->ws;
    const int tid = opq_v(threadIdx.x), wid = __builtin_amdgcn_readfirstlane(tid >> 6), lane = tid & 63;
    const int rl0 = opq_v(wr * 64 + fr), cl0 = opq_v(wc * 32 + 8 * fq);
    const h16* xb = (const h16*)(ws + WS_XB);
    LAS float* Pt = (LAS float*)(lds + EX_P_OFF);
    LAS float* St = (LAS float*)(lds + EX_S_OFF);
    volatile LAS unsigned* flag = (volatile LAS unsigned*)(lds + EX_FLAG_OFF);
    float* slots = (float*)(ws + WS_CTL + CTL_XS);
    unsigned* cnt = (unsigned*)(ws + WS_CTL + CTL_XCNT) + 64 * u.pm;
#pragma unroll
    for (int ai = 0; ai < 2; ++ai) {
        u32x4 rV[4][2];
#pragma unroll
        for (int m = 0; m < 4; ++m)
#pragma unroll
            for (int bj = 0; bj < 2; ++bj) rV[m][bj] = *(const u32x4*)(xb + ((size_t)u.pm * 256 + 128 * ai + 16 * m + rl0) * 1024 + 256 * u.pn + cl0 + 128 * bj);
        __builtin_amdgcn_sched_barrier(0);
#pragma unroll
        for (int m = 0; m < 4; ++m) {
            float sq = 0.f;
#pragma unroll
            for (int bj = 0; bj < 2; ++bj) {
                const u32x4 rv = rV[m][bj];
                const f32x2 a0 = unpkh(rv.x), a1 = unpkh(rv.y), a2 = unpkh(rv.z), a3 = unpkh(rv.w);
                f32x4 v0 = acc[ai][bj][m][0], v1 = acc[ai][bj][m][1];
                v0[0] += a0.x; v0[1] += a0.y; v0[2] += a1.x; v0[3] += a1.y; v1[0] += a2.x; v1[1] += a2.y; v1[2] += a3.x; v1[3] += a3.y;
                acc[ai][bj][m][0] = v0; acc[ai][bj][m][1] = v1;
                sq += (v0[0] * v0[0] + v0[1] * v0[1]) + (v0[2] * v0[2] + v0[3] * v0[3]) + (v1[0] * v1[0] + v1[1] * v1[1]) + (v1[2] * v1[2] + v1[3] * v1[3]);
            }
            sq += __shfl_xor(sq, 16); sq += __shfl_xor(sq, 32);
            if (fq == 0) Pt[(128 * ai + 16 * m + rl0) * 4 + wc] = sq;
            asm volatile("" : "+v"(acc[ai][0][m][0]), "+v"(acc[ai][0][m][1]), "+v"(acc[ai][1][m][0]), "+v"(acc[ai][1][m][1]) :: "memory");
        }
    }
    asm volatile("s_waitcnt lgkmcnt(0)" ::: "memory"); __builtin_amdgcn_s_barrier(); asm volatile("" ::: "memory");
    if (tid < 256) {
        const f32x4 p4 = *(const LAS f32x4*)(Pt + tid * 4);
        __hip_atomic_store(slots + ((size_t)u.pm * 4 + u.pn) * 256 + tid, (p4[0] + p4[1]) + (p4[2] + p4[3]), __ATOMIC_RELAXED, __HIP_MEMORY_SCOPE_AGENT);
        asm volatile("s_waitcnt vmcnt(0)" ::: "memory");
        if (lane == 0) __hip_atomic_fetch_add(cnt, 1u, __ATOMIC_RELAXED, __HIP_MEMORY_SCOPE_AGENT);
    }
    if (wid == 0) {
        unsigned sp = 0; bool dead = false;
        while ((unsigned)__builtin_amdgcn_readfirstlane(__hip_atomic_load(cnt, __ATOMIC_RELAXED, __HIP_MEMORY_SCOPE_AGENT)) < 16u) {
            __builtin_amdgcn_s_sleep(2);
            if (++sp > (1u << 20)) { dead = true; break; }
        }
        __builtin_amdgcn_fence(__ATOMIC_ACQUIRE, "agent");
        if (lane == 0) { flag[0] = dead ? 1u : 0u; if (dead) __hip_atomic_store((unsigned*)(ws + WS_CTL + CTL_BAR) + XB_TMO, 1u, __ATOMIC_RELAXED, __HIP_MEMORY_SCOPE_AGENT); }
    }
    asm volatile("s_waitcnt vmcnt(0) lgkmcnt(0)" ::: "memory"); __builtin_amdgcn_s_barrier(); asm volatile("" ::: "memory");
    if (tid < 256) {
        const float* sl = slots + (size_t)u.pm * 4 * 256 + tid;
        float tot = 0.f;
#pragma unroll
        for (int t = 0; t < 4; ++t) tot += __hip_atomic_load(sl + t * 256, __ATOMIC_RELAXED, __HIP_MEMORY_SCOPE_AGENT);
        St[tid] = rsqrtf(tot * (1.f / D) + EPS);
    }
    asm volatile("s_waitcnt lgkmcnt(0)" ::: "memory"); __builtin_amdgcn_s_barrier(); asm volatile("" ::: "memory");
    f32x4 gv[2][2];
#pragma unroll
    for (int bj = 0; bj < 2; ++bj)
#pragma unroll
        for (int n = 0; n < 2; ++n) gv[bj][n] = *(const f32x4*)(P->final_g + 256 * u.pn + 128 * bj + cl0 + 4 * n);
    float* xo = P->out;
#pragma unroll
    for (int ai = 0; ai < 2; ++ai)
#pragma unroll
        for (int m = 0; m < 4; ++m) {
            const int rl = 128 * ai + 16 * m + rl0;
            const float rs = St[rl];
            const size_t off = ((size_t)u.pm * 256 + rl) * 1024 + 256 * u.pn + cl0;
#pragma unroll
            for (int bj = 0; bj < 2; ++bj) { *(f32x4*)(xo + off + 128 * bj) = acc[ai][bj][m][0] * rs * gv[bj][0]; *(f32x4*)(xo + off + 128 * bj + 4) = acc[ai][bj][m][1] * rs * gv[bj][1]; }
        }
}
__device__ __forceinline__ void acc_handover(f32x4 (&acc)[2][2][4][2], const Unit& u, KP P, int wr, int wc, int fr, int fq) {
    unsigned char* ws = P->ws;
    const bool keep = (u.mode == M_YB) && (u.aux < 2);
    {
        int zi = __builtin_amdgcn_readfirstlane(keep ? 0x3f800000 : 0);
        asm volatile("" : "+s"(zi));
        const float z = __builtin_bit_cast(float, zi);
#pragma unroll
        for (int ai = 0; ai < 2; ++ai)
#pragma unroll
            for (int bj = 0; bj < 2; ++bj)
#pragma unroll
                for (int m = 0; m < 4; ++m) { acc[ai][bj][m][0] *= z; acc[ai][bj][m][1] *= z; }
    }
    if (!keep) return;
    const int rl0 = opq_v(wr * 64 + fr), cl0 = opq_v(wc * 32 + 8 * fq);
    const unsigned char* gk = ws + WS_REG + (size_t)(u.pm >> 3) * REG_B + gs_native(u.pm, u.pn, u.aux, rl0, cl0);
#pragma unroll
    for (int ai = 0; ai < 2; ++ai) {
        u32x4 gA[4], gB[4];
#pragma unroll
        for (int m = 0; m < 4; ++m) { gA[m] = *(const u32x4*)(gk + 8192 * (ai * 4 + m)); gB[m] = *(const u32x4*)(gk + 65536 + 8192 * (ai * 4 + m)); }
        __builtin_amdgcn_sched_barrier(0);
#pragma unroll
        for (int m = 0; m < 4; ++m) {
#pragma unroll
            for (int bj = 0; bj < 2; ++bj) {
                acc[ai][bj][m][0] *= gate_u4(gA[m][2 * bj]) * rcp4(gate_u4(gB[m][2 * bj]));
                acc[ai][bj][m][1] *= gate_u4(gA[m][2 * bj + 1]) * rcp4(gate_u4(gB[m][2 * bj + 1]));
            }
            if (m == 3) asm volatile("" : "+v"(acc[ai][0][0][0]), "+v"(acc[ai][0][0][1]), "+v"(acc[ai][1][0][0]), "+v"(acc[ai][1][0][1]), "+v"(acc[ai][0][1][0]), "+v"(acc[ai][0][1][1]), "+v"(acc[ai][1][1][0]), "+v"(acc[ai][1][1][1]),
                                             "+v"(acc[ai][0][2][0]), "+v"(acc[ai][0][2][1]), "+v"(acc[ai][1][2][0]), "+v"(acc[ai][1][2][1]), "+v"(acc[ai][0][3][0]), "+v"(acc[ai][0][3][1]), "+v"(acc[ai][1][3][0]), "+v"(acc[ai][1][3][1]) :: "memory");
        }
    }
}

__device__ __forceinline__ void gemm_phase(LAS unsigned char* lds, const Sched& Sc, KP P) {
    const int tid = opq_v(threadIdx.x), wid = __builtin_amdgcn_readfirstlane(tid >> 6), lane = tid & 63, wr = wid >> 2, wc = wid & 3, fr = lane & 15, fq = lane >> 4;
    int rA[2], rB[2], rX[2], c2[2];
#pragma unroll
    for (int i = 0; i < 2; ++i) { int R, C; stage_rc(tid * 16 + i * 8192, R, C); rA[i] = R; rB[i] = (R & ~31) + perm32(R & 31); rX[i] = 32 * (rB[i] & 63) + (rB[i] >> 6); c2[i] = C * 2; }
    const unsigned ldsw = (unsigned)wid * 1024u;
    const int aoff = lds_byte(wr * 64 + fr, fq * 8), boff = lds_byte(wc * 32 + fr, fq * 8);
#define G_SA(b, h) (((b) * 2 + (h)) * HTB)
#define G_SB(b, h) ((4 + (b) * 2 + (h)) * HTB)
#define G_STAGE(bufoff, base, ld2, hrow, koff, r0, r1) do { \
        __builtin_amdgcn_global_load_lds((const unsigned*)((base) + (size_t)(unsigned)(((r0) + (hrow)) * (ld2) + c2[0] + (koff))), (LAS unsigned*)(lds + (bufoff) + ldsw), 16, 0, 0); \
        __builtin_amdgcn_global_load_lds((const unsigned*)((base) + (size_t)(unsigned)(((r1) + (hrow)) * (ld2) + c2[1] + (koff))), (LAS unsigned*)(lds + (bufoff) + ldsw + 8192), 16, 0, 0); } while (0)
#define G_STA(bufoff, base, ld2, h, koff) G_STAGE(bufoff, base, ld2, 128 * (h), koff, rA[0], rA[1])
#define G_LDA(dst, b, h) do { _Pragma("unroll") for (int m = 0; m < 4; ++m) _Pragma("unroll") for (int k = 0; k < 2; ++k) dst[m][k] = *(const LAS h16x8*)(lds + G_SA(b, h) + aoff + m * 2048 + k * 1024); } while (0)
#define G_LDB(dst, b, h) do { _Pragma("unroll") for (int n = 0; n < 2; ++n) _Pragma("unroll") for (int k = 0; k < 2; ++k) dst[n][k] = *(const LAS h16x8*)(lds + G_SB(b, h) + boff + n * 2048 + k * 1024); } while (0)
#define G_MMA(ai, bj, At, Bt) do { __builtin_amdgcn_s_setprio(1); _Pragma("unroll") for (int m = 0; m < 4; ++m) _Pragma("unroll") for (int n = 0; n < 2; ++n) _Pragma("unroll") for (int k = 0; k < 2; ++k) \
        acc[ai][bj][m][n] = MFMA16(Bt[n][k], At[m][k], acc[ai][bj][m][n]); __builtin_amdgcn_s_setprio(0); } while (0)
#define G_WAIT_V(n) asm volatile("s_waitcnt vmcnt(" #n ")" ::: "memory")
#define G_WAIT_L(n) asm volatile("s_waitcnt lgkmcnt(" #n ")" ::: "memory")
#define G_BAR __builtin_amdgcn_s_barrier()
#define G_SCHED __builtin_amdgcn_sched_barrier(0)
    Unit cur, nxt; int ui = 0;
    if (!Sc.next(0, cur)) return;
    f32x4 acc[2][2][4][2];
#pragma unroll
    for (int a = 0; a < 2; ++a)
#pragma unroll
        for (int b = 0; b < 2; ++b)
#pragma unroll
            for (int m = 0; m < 4; ++m)
#pragma unroll
                for (int n = 0; n < 2; ++n) acc[a][b][m][n] = (f32x4){0.f, 0.f, 0.f, 0.f};
    h16x8 At[4][2], B0[2][2], B1[2][2];
    { const int q0 = cur.bperm ? rX[0] : rB[0], q1 = cur.bperm ? rX[1] : rB[1], hm = cur.bperm ? 2 : 128;
      G_STAGE(G_SB(0, 0), cur.B, cur.ldb2, 0, 0, q0, q1); G_STAGE(G_SB(0, 1), cur.B, cur.ldb2, hm, 0, q0, q1); G_STA(G_SA(0, 0), cur.A, cur.lda2, 0, 0); G_STA(G_SA(0, 1), cur.A, cur.lda2, 1, 0);
      if (wr == 1) G_BAR;
      G_WAIT_V(2); G_BAR;
      G_STAGE(G_SB(1, 0), cur.B, cur.ldb2, 0, KSTEP, q0, q1); G_STAGE(G_SB(1, 1), cur.B, cur.ldb2, hm, KSTEP, q0, q1);
      G_WAIT_V(6); G_BAR; }
    for (;;) {
        const bool has_next = Sc.next(ui + 1, nxt);
        const char* nA = has_next ? nxt.A : cur.A; const char* nB = has_next ? nxt.B : cur.B;
        const int nlda = has_next ? nxt.lda2 : cur.lda2, nldb = has_next ? nxt.ldb2 : cur.ldb2, nbp = has_next ? nxt.bperm : cur.bperm;
        const int nt = cur.nt;
        for (int t = 0; t < nt; t += 2) {
            const bool last = (t == nt - 2);
            const int k1 = (t + 1) * KSTEP;
            const char* a2 = last ? nA : cur.A; const char* b2 = last ? nB : cur.B;
            const int la2 = last ? nlda : cur.lda2, lb2 = last ? nldb : cur.ldb2;
            const int k2 = last ? 0 : (t + 2) * KSTEP, k3 = k2 + KSTEP;
            const int bp2 = last ? nbp : cur.bperm;
            const int q0 = bp2 ? rX[0] : rB[0], q1 = bp2 ? rX[1] : rB[1], hm = bp2 ? 2 : 128;
            if (last && cur.ssp) {
                const int j = (wid & 3) * 64 + lane;
                const float* src = (wid < 4) ? cur.ssp + (cur.ssperm ? 32 * (j & 63) + (j >> 6) : j) : cur.bip + j;
                __builtin_amdgcn_global_load_lds((const unsigned*)src, (LAS unsigned*)(lds + (wid < 4 ? EPI_SS_OFF : EPI_BIAS_OFF) + (wid & 3) * 256), 4, 0, 0);
            }
            G_LDB(B0, 0, 0); G_LDB(B1, 0, 1); G_SCHED; G_LDA(At, 0, 0); G_STA(G_SA(1, 0), cur.A, cur.lda2, 0, k1); G_STA(G_SA(1, 1), cur.A, cur.lda2, 1, k1);
            G_WAIT_V(8); G_WAIT_L(0); G_BAR; G_MMA(0, 0, At, B0); G_MMA(0, 1, At, B1); G_BAR; G_SCHED;
            G_LDA(At, 0, 1); G_STAGE(G_SB(0, 0), b2, lb2, 0, k2, q0, q1); G_STAGE(G_SB(0, 1), b2, lb2, hm, k2, q0, q1);
            G_WAIT_V(6); G_WAIT_L(0); G_BAR; G_MMA(1, 0, At, B0); G_MMA(1, 1, At, B1); G_BAR; G_SCHED;
            G_LDB(B0, 1, 0); G_LDB(B1, 1, 1); G_SCHED; G_LDA(At, 1, 0); G_STA(G_SA(0, 0), a2, la2, 0, k2); G_STA(G_SA(0, 1), a2, la2, 1, k2);
            G_WAIT_V(8); G_WAIT_L(0); G_BAR; G_MMA(0, 0, At, B0); G_MMA(0, 1, At, B1); G_BAR; G_SCHED;
            G_LDA(At, 1, 1); G_STAGE(G_SB(1, 0), b2, lb2, 0, k3, q0, q1); G_STAGE(G_SB(1, 1), b2, lb2, hm, k3, q0, q1);
            G_WAIT_V(6); G_WAIT_L(0); G_BAR; G_MMA(1, 0, At, B0); G_MMA(1, 1, At, B1); G_BAR; G_SCHED;
        }
        if (ui == 0 && Sc.arr != nullptr && wid == 0) {
            XB_SPIN(xb_ld(&Sc.arr[XB_ARR(Sc.layer)]) < 32u, Sc.arr);
            asm volatile("buffer_inv sc1" ::: "memory");
        }
        if (wr == 0) G_BAR;
        if (cur.mode == M_OUT && Sc.layer == DEPTH - 1) epi_out_last(acc, cur, P, lds, wr, wc, fr, fq);
        else epilogue(acc, cur, P, lds, Sc.layer, wr, wc, fr, fq);
        if (!has_next) break;
        acc_handover(acc, cur, P, wr, wc, fr, fq);
        cur = nxt; ++ui;
        if (wr == 1) G_BAR;
    }
    G_WAIT_V(0);
    G_BAR;
#undef G_SA
#undef G_SB
#undef G_STAGE
#undef G_STA
#undef G_LDA
#undef G_LDB
#undef G_MMA
#undef G_WAIT_V
#undef G_WAIT_L
#undef G_BAR
#undef G_SCHED
}

__device__ __forceinline__ void p0_transpose_item(const float* W, int Nsrc, int k0, int c0, h16* dst, int dpitch, int r0, const float* gk, LAS float* scr, int lane) {
    float tv[32];
#pragma unroll
    for (int i = 0; i < 32; ++i) tv[i] = W[(size_t)(k0 + 2 * i + (lane >> 5)) * Nsrc + c0 + (lane & 31)];
    if (gk) {
#pragma unroll
        for (int i = 0; i < 32; ++i) tv[i] *= gk[k0 + 2 * i + (lane >> 5)]; }
#pragma unroll
    for (int i = 0; i < 32; ++i) scr[(2 * i + (lane >> 5)) * 33 + (lane & 31)] = tv[i];
    LDS_WAIT(); asm volatile("" ::: "memory");
    const int c = lane & 7;
#pragma unroll
    for (int j = 0; j < 4; ++j) { const int n = (lane >> 3) + 8 * j; const LAS float* s = scr + (8 * c) * 33 + n;
        u32x4 o; o.x = pkw(s[0 * 33], s[1 * 33]); o.y = pkw(s[2 * 33], s[3 * 33]); o.z = pkw(s[4 * 33], s[5 * 33]); o.w = pkw(s[6 * 33], s[7 * 33]);
        st16_wt(dst, (unsigned)((r0 + n) * dpitch + k0 + 8 * c) * 2u, o); }
    LDS_WAIT(); asm volatile("" ::: "memory");
}
__device__ __forceinline__ int inproj_col(int r) {
    if (r >= 5120) return 4608 + (r - 5120);
    const int j = (r - 1024) >> 8, q = (r - 1024) & 255, hf = q >> 7, i = q & 127;
    if (j < 2) return 512 + 256 * j + q;
    if (j < 6) return (hf ? 1536 : 1024) + 128 * (j - 2) + i;
    if (j < 8) return 2048 + 256 * (j - 6) + q;
    if (j < 12) return (hf ? 3584 : 3072) + 128 * (j - 8) + i;
    return (hf ? 4096 : 2560) + 128 * (j - 12) + i;
}
__device__ __forceinline__ void p0_fold_item(KP P, int item, LAS unsigned char* lds) {
    const int tid = opq_v(threadIdx.x); unsigned char* ws = P->ws;
    const int l = item >> 7, gr = (item >> 5) & 3, kb = item & 31, k0 = kb * 32;
    LAS float* Wt = (LAS float*)lds;
    LAS float* cosT = Wt + 128 * 36; LAS float* sinT = cosT + 128;
    const float* W = P->w_in + (size_t)l * D * INW;
    const float* g = P->norm_g + l * D;
    __syncthreads();
    if (tid < 128) { cosT[tid] = cospif(tid * (1.f / 64.f)); sinT[tid] = sinpif(tid * (1.f / 64.f)); }
#pragma unroll
    for (int j = 0; j < 8; ++j) { const int n2 = tid & 127, kk = (tid >> 7) + 4 * j; Wt[n2 * 36 + kk] = W[(size_t)(k0 + kk) * INW + gr * 128 + n2] * g[k0 + kk]; }
    __syncthreads();
    const int pp = tid & 63, kq = __builtin_amdgcn_readfirstlane(tid >> 6);
    f32x4 ec = {0.f, 0.f, 0.f, 0.f}, es = ec, oc = ec, os = ec;
    float bec = 0.f, bes = 0.f, boc = 0.f, bos = 0.f;
    const float* bin = P->b_in + (size_t)l * INW + gr * 128;
    const bool dob = (kb == 0 && kq == 0);
#pragma unroll 4
    for (int m = 0; m < 64; ++m) {
        const int ie = (pp * 2 * m) & 127, io = (pp * (2 * m + 1)) & 127;
        const float ce = cosT[ie], se = sinT[ie], co = cosT[io], so = sinT[io];
        const f32x4 we = *(const LAS f32x4*)(Wt + (2 * m) * 36 + kq * 4), wo = *(const LAS f32x4*)(Wt + (2 * m + 1) * 36 + kq * 4);
        ec += we * ce; es += we * se; oc += wo * co; os += wo * so;
        if (dob) { const float b0 = bin[2 * m], b1 = bin[2 * m + 1]; bec += b0 * ce; bes += b0 * se; boc += b1 * co; bos += b1 * so; }
    }
    h16* wi = (h16*)(ws + WS_WI) + (size_t)l * NP * 1024;
    const int r0 = 2 * (gr * 128 + pp), r1 = r0 + 128;
    { const f32x4 c0 = ec + oc, s0 = es + os, c1 = ec - oc, s1 = es - os;
      u32x2 o; o.x = pkw(c0[0], c0[1]); o.y = pkw(c0[2], c0[3]); st8_wt(wi, (unsigned)(r0 * 1024 + k0 + kq * 4) * 2u, o);
      o.x = pkw(s0[0], s0[1]); o.y = pkw(s0[2], s0[3]); st8_wt(wi, (unsigned)((r0 + 1) * 1024 + k0 + kq * 4) * 2u, o);
      o.x = pkw(c1[0], c1[1]); o.y = pkw(c1[2], c1[3]); st8_wt(wi, (unsigned)(r1 * 1024 + k0 + kq * 4) * 2u, o);
      o.x = pkw(s1[0], s1[1]); o.y = pkw(s1[2], s1[3]); st8_wt(wi, (unsigned)((r1 + 1) * 1024 + k0 + kq * 4) * 2u, o); }
    if (dob) { float* biasP = (float*)(ws + WS_CTL + CTL_BIAS) + (size_t)l * NP;
        __hip_atomic_store(biasP + r0, bec + boc, __ATOMIC_RELAXED, __HIP_MEMORY_SCOPE_AGENT); __hip_atomic_store(biasP + r0 + 1, bes + bos, __ATOMIC_RELAXED, __HIP_MEMORY_SCOPE_AGENT);
        __hip_atomic_store(biasP + r1, bec - boc, __ATOMIC_RELAXED, __HIP_MEMORY_SCOPE_AGENT); __hip_atomic_store(biasP + r1 + 1, bes - bos, __ATOMIC_RELAXED, __HIP_MEMORY_SCOPE_AGENT); }
}
__device__ __forceinline__ void p0_weights(KP P, LAS unsigned char* lds, int c, int G, int l) {
    const int tid = opq_v(threadIdx.x), lane = tid & 63, wave = __builtin_amdgcn_readfirstlane(tid >> 6); unsigned char* ws = P->ws;
    for (int it = c; it < 128; it += G) p0_fold_item(P, 128 * l + it, lds);
    __syncthreads();
    LAS float* scr = (LAS float*)(lds + wave * 16384);
    const int gw = c * NWAVES + wave, NGW = G * NWAVES;
    constexpr int I_WI = 16 * 224, I_WB = 8 * 32, I_WO = 16 * 32;
    constexpr int NITEMS = I_WI + 3 * I_WB + I_WO;
    const bool bal = (G == 256);
    const int half_w = 128 * NWAVES, first_n = 4 * half_w;
    const int it0 = bal ? (c >= 128 ? gw - half_w : first_n + gw) : gw, its = bal ? half_w : NGW, itend = bal ? (c >= 128 ? first_n : NITEMS) : NITEMS;
    for (int it = it0; it < itend; it += its) {
        int r = it;
        if (r < I_WI) { const int kb = r / 224, rb = r % 224, r0 = 1024 + 32 * rb;
            p0_transpose_item(P->w_in + (size_t)l * D * INW, INW, 64 * kb, inproj_col(r0), (h16*)(ws + WS_WI) + (size_t)l * NP * 1024, 1024, r0, P->norm_g + l * D, scr, lane); continue; }
        r -= I_WI;
        if (r < 3 * I_WB) { const int lk = 3 * l + r / I_WB; r %= I_WB; const int kb = r / 32, rb = r % 32;
            p0_transpose_item(P->w_branch + (size_t)lk * BW * D, D, 64 * kb, 32 * rb, (h16*)(ws + WS_WB) + (size_t)lk * 1024 * 512, 512, 32 * rb, nullptr, scr, lane); continue; }
        r -= 3 * I_WB;
        { const int kb = r / 32, rb = r % 32;
            p0_transpose_item(P->w_out + (size_t)l * D * D, D, 64 * kb, 32 * rb, (h16*)(ws + WS_WO) + (size_t)l * 1024 * 1024, 1024, 32 * rb, nullptr, scr, lane); }
    }
    { float* biasP = (float*)(ws + WS_CTL + CTL_BIAS) + (size_t)l * NP;
      for (int i = c * NTHREADS + tid; i < NP - 1024; i += G * NTHREADS) { const int r = 1024 + i; __hip_atomic_store(biasP + r, P->b_in[(size_t)l * INW + inproj_col(r)], __ATOMIC_RELAXED, __HIP_MEMORY_SCOPE_AGENT); } }
    __syncthreads();
}
__device__ __forceinline__ void fft_build_tables(KP P, LAS unsigned char* lds, int part);
__device__ __forceinline__ void p0_prologue(KP P, LAS unsigned char* lds, int c, int G) {
    p0_weights(P, lds, c, G, 0);
    const int tid = opq_v(threadIdx.x), lane = tid & 63, wave = __builtin_amdgcn_readfirstlane(tid >> 6); unsigned char* ws = P->ws;
    const int gw = c * NWAVES + wave, NGW = G * NWAVES;
    if (c >= G - 32) fft_build_tables(P, lds, c - (G - 32));
    { float* ss1 = (float*)(ws + WS_CTL + CTL_SS) + T; for (int i = c * NTHREADS + tid; i < T; i += G * NTHREADS) ss1[i] = 0.f;
      unsigned* xc = (unsigned*)(ws + WS_CTL + CTL_XCNT); for (int i = c * NTHREADS + tid; i < 4096; i += G * NTHREADS) xc[i] = 0u;
      if (c == 1 && tid < 128) ((unsigned*)(ws + WS_CTL + CTL_DUMMY))[tid] = 0u;
      if (c >= 8 && c < 16) { unsigned* gb = (unsigned*)(ws + WS_CTL + CTL_GBAR) + 4096 * (c - 8); for (int i = tid; i < XCD_BAR_WORDS; i += NTHREADS) gb[i] = 0u; }
      if (c == 16 && tid < 16) ((unsigned*)(ws + WS_CTL + CTL_PREP))[tid] = 0u; }
    if (c == 0 && tid < 128) ((unsigned*)(ws + WS_CTL + CTL_DUMMY + 2048))[tid] = USE_BF16 ? 0x3F803F80u : 0x3C003C00u;
    if (c == 0 && tid == 128) *(float*)(ws + WS_CTL + CTL_DUMMY + 2048 + 512) = 1.0f;
    { float* ss0 = (float*)(ws + WS_CTL + CTL_SS); h16* xb = (h16*)(ws + WS_XB);
      for (int row = gw; row < T; row += 2 * NGW) {
          const int row2 = row + NGW;
          const f32x4* xr = (const f32x4*)(P->x + (size_t)row * D) + lane; const f32x4* xq = (const f32x4*)(P->x + (size_t)(row2 < T ? row2 : row) * D) + lane;
          f32x4 v[4], w[4]; float s = 0.f, s2 = 0.f;
#pragma unroll
          for (int j = 0; j < 4; ++j) { v[j] = xr[64 * j]; w[j] = xq[64 * j]; }
#pragma unroll
          for (int j = 0; j < 4; ++j) { s += (v[j][0] * v[j][0] + v[j][1] * v[j][1]) + (v[j][2] * v[j][2] + v[j][3] * v[j][3]); s2 += (w[j][0] * w[j][0] + w[j][1] * w[j][1]) + (w[j][2] * w[j][2] + w[j][3] * w[j][3]); }
          s = wave_sum(s); s2 = wave_sum(s2);
          if (lane == 0) { ss0[row] = s; if (row2 < T) ss0[row2] = s2; }
          u32x2* o = (u32x2*)(xb + (size_t)row * D) + lane;
#pragma unroll
          for (int j = 0; j < 4; ++j) { u32x2 t; t.x = pkh(v[j][0], v[j][1]); t.y = pkh(v[j][2], v[j][3]); o[64 * j] = t; }
          if (row2 < T) { u32x2* o2 = (u32x2*)(xb + (size_t)row2 * D) + lane;
#pragma unroll
              for (int j = 0; j < 4; ++j) { u32x2 t; t.x = pkh(w[j][0], w[j][1]); t.y = pkh(w[j][2], w[j][3]); o2[64 * j] = t; } }
      } }
}
constexpr int FFT_W1_OFF = 0, FFT_TW_OFF = 32768, FFT_ST_OFF = 49152, FFT_LUT_OFF = FFT_ST_OFF + 65536;
static_assert(FFT_LUT_OFF + 256 <= MISC_OFF, "lds map (fft)");
__device__ __forceinline__ void fft_build_tables(KP P, LAS unsigned char* lds, int part) {
    const int tid = opq_v(threadIdx.x);
    unsigned char* tab = P->ws + WS_TAB;
    if (part == 0 && tid < 64) ((float*)(tab + 49152))[tid] = cospif(tid * (1.f / 32.f));
    {
        const int idx = part * NTHREADS + tid;
        const int frag = idx >> 9, nt = frag >> 2, st = frag & 3, ln = (idx >> 3) & 63, e = idx & 7;
        const int kk = 32 * st + 8 * (ln >> 4) + e, j = 16 * nt + (ln & 15), csi = kk >> 6, n_hi = kk & 63, reim = j >> 6, k_lo = j & 63, a = (k_lo * n_hi) & 63;
        const float c = cospif(a * (1.f / 32.f)), sn = sinpif(a * (1.f / 32.f));
        ((h16*)tab)[idx] = (h16)(reim == 0 ? (csi == 0 ? c : -sn) : (csi == 0 ? -sn : -c));
    }
    if (tid < 64) {
        const int idx = part * 64 + tid; const float x = (float)((idx >> 6) * (idx & 63)) * (1.f / 1024.f);
        ((f32x2*)(tab + 32768))[idx] = (f32x2){cospif(x), sinpif(x)};
    }
}
static_assert(FFT_W1_OFF == 0 && FFT_TW_OFF == 32768, "table image layout");
__device__ __forceinline__ void fft_load_tables(KP P, LAS unsigned char* lds) {
    const int tid = opq_v(threadIdx.x);
    const u32x4* src = (const u32x4*)(P->ws + WS_TAB);
    __syncthreads();
    u32x4 v[6];
#pragma unroll
    for (int i = 0; i < 6; ++i) v[i] = src[tid + i * NTHREADS];
#pragma unroll
    for (int i = 0; i < 6; ++i) *(LAS u32x4*)(lds + (tid + i * NTHREADS) * 16) = v[i];
    if (tid < 16) *(LAS u32x4*)(lds + FFT_LUT_OFF + tid * 16) = src[3072 + tid];
    __syncthreads();
}
__device__ __forceinline__ void fft_unit(KP P, int unit, LAS unsigned char* lds) {
    const int tid = opq_v(threadIdx.x), lane = tid & 63, wave = __builtin_amdgcn_readfirstlane(tid >> 6), fr = lane & 15, fq = lane >> 4;
    unsigned char* ws = P->ws;
    const int b = unit & 7, cblk = unit >> 3;
    const LAS float* lut = (const LAS float*)(lds + FFT_LUT_OFF);
    const LAS f32x2* tw = (const LAS f32x2*)(lds + FFT_TW_OFF);
    h16x8 W3[2][2];
#pragma unroll
    for (int mt3 = 0; mt3 < 2; ++mt3)
#pragma unroll
        for (int st = 0; st < 2; ++st)
#pragma unroll
            for (int e = 0; e < 8; ++e) { const int a = ((16 * mt3 + fr) * (16 * st + 4 * fq + (e & 3))) & 31; W3[mt3][st][e] = (h16)((e >> 2) ? lut[(2 * a - 16) & 63] : lut[2 * a]); }
    f32x4 D3[2][2][4];
#pragma unroll
    for (int chi = 0; chi < 2; ++chi) {
        const h16* xt = (const h16*)(ws + WS_REG + (size_t)b * REG_B) + (size_t)(2 * (16 * cblk + 2 * wave + chi)) * 2048;
        h16x8 A[2][4];
#pragma unroll
        for (int mt = 0; mt < 2; ++mt)
#pragma unroll
            for (int st = 0; st < 4; ++st) A[mt][st] = *(const h16x8*)(xt + (size_t)(st >> 1) * 2048 + (16 * mt + fr) * 64 + 32 * (st & 1) + 8 * fq);
        f32x4 D1[2][8];
#pragma unroll
        for (int nt = 0; nt < 8; ++nt) {
            h16x8 Bf[4];
#pragma unroll
            for (int st = 0; st < 4; ++st) Bf[st] = *(const LAS h16x8*)(lds + FFT_W1_OFF + (nt * 4 + st) * 1024 + lane * 16);
#pragma unroll
            for (int mt = 0; mt < 2; ++mt) {
                f32x4 d = (f32x4){0.f, 0.f, 0.f, 0.f};
#pragma unroll
                for (int st = 0; st < 4; ++st) d = MFMA16(A[mt][st], Bf[st], d);
                D1[mt][nt] = d;
            }
        }
#pragma unroll
        for (int mt3 = 0; mt3 < 2; ++mt3)
#pragma unroll
            for (int ntp = 0; ntp < 4; ++ntp) D3[chi][mt3][ntp] = (f32x4){0.f, 0.f, 0.f, 0.f};
#pragma unroll
        for (int mt = 0; mt < 2; ++mt)
#pragma unroll
            for (int ntp = 0; ntp < 4; ++ntp) {
                float vr[4], vi[4];
#pragma unroll
                for (int jj = 0; jj < 4; ++jj) {
                    const f32x2 t = tw[(16 * mt + 4 * fq + jj) * 64 + 16 * ntp + fr];
                    const float ur = D1[mt][ntp][jj], ui = D1[mt][ntp + 4][jj];
                    vr[jj] = ur * t.x + ui * t.y; vi[jj] = ui * t.x - ur * t.y;
                }
                u32x4 pk; pk.x = pkh(vr[0], vr[1]); pk.y = pkh(vr[2], vr[3]); pk.z = pkh(vi[0], vi[1]); pk.w = pkh(vi[2], vi[3]);
                const h16x8 vf = __builtin_bit_cast(h16x8, pk);
#pragma unroll
                for (int mt3 = 0; mt3 < 2; ++mt3) D3[chi][mt3][ntp] = MFMA16(W3[mt3][mt], vf, D3[chi][mt3][ntp]);
            }
    }
    LAS unsigned* stg = (LAS unsigned*)(lds + FFT_ST_OFF);
#pragma unroll
    for (int mt3 = 0; mt3 < 2; ++mt3)
#pragma unroll
        for (int ntp = 0; ntp < 4; ++ntp)
#pragma unroll
            for (int jj = 0; jj < 4; ++jj) { const int k1 = 16 * ntp + fr + 64 * (16 * mt3 + 4 * fq + jj); stg[k1 * 8 + wave] = pkh(D3[0][mt3][ntp][jj], D3[1][mt3][ntp][jj]); }
    __syncthreads();
    {
        const h16* zf = (const h16*)(ws + WS_REG + (size_t)b * REG_B + REG_PA);
        h16* Y = (h16*)(ws + WS_Y);
        const int hf = tid & 1;
        u32x4 zq[8];
#pragma unroll
        for (int i = 0; i < 8; ++i) zq[i] = *(const u32x4*)(zf + (size_t)((tid >> 1) + 256 * i) * 512 + 16 * cblk + 8 * hf);
#pragma unroll
        for (int i = 0; i < 8; ++i) {
            const int k1 = (tid >> 1) + 256 * i;
            const size_t tok = (size_t)b * S + k1;
            const u32x4 sv = *(const LAS u32x4*)(lds + FFT_ST_OFF + k1 * 32 + hf * 16);
            const u32x4 zv = zq[i];
            const f32x2 s0 = unpkh(sv.x), s1 = unpkh(sv.y), s2 = unpkh(sv.z), s3 = unpkh(sv.w);
            f32x2 z0 = unpkh(zv.x), z1 = unpkh(zv.y), z2 = unpkh(zv.z), z3 = unpkh(zv.w);
            { const f32x4 za = (f32x4){z0.x, z0.y, z1.x, z1.y}, zb = (f32x4){z2.x, z2.y, z3.x, z3.y}; const f32x4 ga = za * sigmoid4(za), gb = zb * sigmoid4(zb);
              z0 = (f32x2){ga[0], ga[1]}; z1 = (f32x2){ga[2], ga[3]}; z2 = (f32x2){gb[0], gb[1]}; z3 = (f32x2){gb[2], gb[3]}; }
            const float k = 1.f / 512.f;
            u32x4 o; o.x = pkh(s0.x * z0.x * k, s0.y * z0.y * k); o.y = pkh(s1.x * z1.x * k, s1.y * z1.y * k); o.z = pkh(s2.x * z2.x * k, s2.y * z2.y * k); o.w = pkh(s3.x * z3.x * k, s3.y * z3.y * k);
            *(u32x4*)(Y + tok * 1536 + 16 * cblk + 8 * hf) = o;
        }
    }
    __syncthreads();
}

__device__ __forceinline__ void conv_unit(KP P, int layer, int unit, LAS unsigned char* lds) {
    const int tid = opq_v(threadIdx.x), lane = tid & 63, wave = __builtin_amdgcn_readfirstlane(tid >> 6); unsigned char* ws = P->ws;
    const int t0 = unit * 64, b = t0 >> 11, s0 = t0 & 2047;
    const h16* cg = (const h16*)(ws + WS_REG + (size_t)b * REG_B + REG_PA + 1 * PA_STEP);
    const h16* zc = (const h16*)(ws + WS_REG + (size_t)b * REG_B + REG_PA + 2 * PA_STEP);
    h16* Y = (h16*)(ws + WS_Y);
    LAS unsigned char* tile = lds;
    LAS h16* O = (LAS h16*)(lds + CONV_O_OFF);
    const int p2 = tid & 255, th = tid >> 8;
    f32x2 w[32];
    {
        const float* cw = P->conv_c_w + (size_t)layer * CK * BW + 2 * p2;
#pragma unroll
        for (int j = 0; j < 31; ++j) w[j] = *(const f32x2*)(cw + j * BW);
        w[31] = (f32x2){0.f, 0.f};
    }
    const f32x2 bias = *(const f32x2*)(P->conv_c_b + layer * BW + 2 * p2);
    __syncthreads();
    {
        u32x4 tv[12];
#pragma unroll
        for (int j = 0; j < 12; ++j) {
            const int q = tid + j * NTHREADS, i = q >> 6, ck = q & 63, sq = s0 - 15 + i;
            tv[j] = (u32x4){0u, 0u, 0u, 0u};
            if (i < 94 && sq >= 0 && sq < S) tv[j] = *(const u32x4*)(cg + (size_t)sq * 512 + ck * 8);
        }
#pragma unroll
        for (int j = 0; j < 12; ++j) { const int q = tid + j * NTHREADS, i = q >> 6, ck = q & 63; if (i < CONV_ROWS) *(LAS u32x4*)(tile + i * 1024 + ck * 16) = tv[j]; }
    }
    u32x4 zr[8];
#pragma unroll
    for (int i = 0; i < 8; ++i) zr[i] = *(const u32x4*)(zc + (size_t)(s0 + 8 * wave + i) * 512 + 8 * lane);
    __syncthreads();
    {
        f32x2 win[32];
        const LAS unsigned* tp = (const LAS unsigned*)tile + (32 * th) * 256 + p2;
#pragma unroll
        for (int j = 0; j < 31; ++j) win[j] = unpkh(tp[j * 256]);
        win[31] = (f32x2){0.f, 0.f};
        LAS unsigned* Op = (LAS unsigned*)O + (32 * th) * 256 + p2;
#pragma unroll
        for (int tt = 0; tt < 32; ++tt) {
            win[(tt + 31) & 31] = unpkh(tp[(tt + 31) * 256]);
            f32x2 o0 = bias, o1 = (f32x2){0.f, 0.f};
#pragma unroll
            for (int j = 0; j < 32; j += 2) { o0 += w[j] * win[(tt + j) & 31]; o1 += w[j + 1] * win[(tt + j + 1) & 31]; }
            o0 += o1;
            Op[tt * 256] = pkh(o0.x, o0.y);
        }
    }
    __syncthreads();
    {
        const float* lg = P->ln_c_g + layer * BW + 8 * lane; const float* lb = P->ln_c_b + layer * BW + 8 * lane;
        float g8[8], b8[8];
#pragma unroll
        for (int e = 0; e < 8; ++e) { g8[e] = lg[e]; b8[e] = lb[e]; }
        float v[8][8], sm[8];
#pragma unroll
        for (int i = 0; i < 8; ++i) {
            const u32x4 ov = *(const LAS u32x4*)(O + (8 * wave + i) * 512 + 8 * lane);
            const f32x2 a0 = unpkh(ov.x), a1 = unpkh(ov.y), a2 = unpkh(ov.z), a3 = unpkh(ov.w);
            v[i][0] = a0.x; v[i][1] = a0.y; v[i][2] = a1.x; v[i][3] = a1.y; v[i][4] = a2.x; v[i][5] = a2.y; v[i][6] = a3.x; v[i][7] = a3.y;
            sm[i] = ((v[i][0] + v[i][1]) + (v[i][2] + v[i][3])) + ((v[i][4] + v[i][5]) + (v[i][6] + v[i][7]));
        }
#pragma unroll
        for (int st = 0; st < 4; ++st)
#pragma unroll
            for (int i = 0; i < 8; ++i) sm[i] = dpp_add(sm[i], st);
#pragma unroll
        for (int o = 16; o < 64; o <<= 1)
#pragma unroll
            for (int i = 0; i < 8; ++i) sm[i] += __shfl_xor(sm[i], o);
#pragma unroll
        for (int i = 0; i < 8; ++i) {
            const float mu = sm[i] * (1.f / BW); float q = 0.f;
#pragma unroll
            for (int e = 0; e < 8; ++e) { v[i][e] -= mu; q += v[i][e] * v[i][e]; }
            sm[i] = q;
        }
#pragma unroll
        for (int st = 0; st < 4; ++st)
#pragma unroll
            for (int i = 0; i < 8; ++i) sm[i] = dpp_add(sm[i], st);
#pragma unroll
        for (int o = 16; o < 64; o <<= 1)
#pragma unroll
            for (int i = 0; i < 8; ++i) sm[i] += __shfl_xor(sm[i], o);
#pragma unroll
        for (int i = 0; i < 8; ++i) {
            const float rstd = rsqrtf(sm[i] * (1.f / BW) + EPS);
            const size_t tok = (size_t)t0 + 8 * wave + i;
            const u32x4 zv = zr[i];
            float z[8]; { const f32x2 a0 = unpkh(zv.x), a1 = unpkh(zv.y), a2 = unpkh(zv.z), a3 = unpkh(zv.w); z[0] = a0.x; z[1] = a0.y; z[2] = a1.x; z[3] = a1.y; z[4] = a2.x; z[5] = a2.y; z[6] = a3.x; z[7] = a3.y; }
            f32x4 l0, l1;
#pragma unroll
            for (int e = 0; e < 4; ++e) { l0[e] = v[i][e] * rstd * g8[e] + b8[e]; l1[e] = v[i][4 + e] * rstd * g8[4 + e] + b8[4 + e]; }
            const f32x4 z0 = (f32x4){z[0], z[1], z[2], z[3]}, z1 = (f32x4){z[4], z[5], z[6], z[7]};
            const f32x4 o0 = (l0 * z0) * silu2den_rcp(l0, z0), o1 = (l1 * z1) * silu2den_rcp(l1, z1);
            u32x4 wv; wv.x = pkh(o0[0], o0[1]); wv.y = pkh(o0[2], o0[3]); wv.z = pkh(o1[0], o1[1]); wv.w = pkh(o1[2], o1[3]);
            *(u32x4*)(Y + tok * 1536 + 512 + 8 * lane) = wv;
        }
    }
    __syncthreads();
}
__device__ __forceinline__ void short_chunk(KP P, int layer, int chunk, int lane_) {
    const int lane = opq_v(lane_); unsigned char* ws = P->ws;
    const int t0 = chunk * 8, s0 = t0 & 2047, b = t0 >> 11;
    const h16* u = (const h16*)(ws + WS_REG + (size_t)b * REG_B + REG_PA + 3 * PA_STEP) + 8 * lane;
    const h16* vv = (const h16*)(ws + WS_REG + (size_t)b * REG_B + REG_PA + 4 * PA_STEP) + 8 * lane;
    h16* Y = (h16*)(ws + WS_Y) + 1024 + 8 * lane;
    u32x4 ur[10], vr[8];
#pragma unroll
    for (int i = 0; i < 10; ++i) { const int sq = s0 - 1 + i; ur[i] = (sq >= 0 && sq < S) ? *(const u32x4*)(u + (size_t)sq * 512) : (u32x4){0u, 0u, 0u, 0u}; }
#pragma unroll
    for (int i = 0; i < 8; ++i) vr[i] = *(const u32x4*)(vv + (size_t)(s0 + i) * 512);
    const float* sw = P->conv_s_w + (size_t)layer * 3 * BW + 8 * lane; const float* sb = P->conv_s_b + layer * BW + 8 * lane;
    float w0[8], w1[8], w2[8], bb[8];
#pragma unroll
    for (int e = 0; e < 8; ++e) { w0[e] = sw[e]; w1[e] = sw[BW + e]; w2[e] = sw[2 * BW + e]; bb[e] = sb[e]; }
#pragma unroll
    for (int i = 0; i < 8; ++i) {
        u32x4 wv;
#pragma unroll
        for (int q = 0; q < 4; ++q) {
            const f32x2 a = unpkh(ur[i][q]), b = unpkh(ur[i + 1][q]), c = unpkh(ur[i + 2][q]), v = unpkh(vr[i][q]);
            wv[q] = pkh(v.x * (w0[2 * q] * a.x + w1[2 * q] * b.x + w2[2 * q] * c.x + bb[2 * q]), v.y * (w0[2 * q + 1] * a.y + w1[2 * q + 1] * b.y + w2[2 * q + 1] * c.y + bb[2 * q + 1]));
        }
        *(u32x4*)(Y + (size_t)(t0 + i) * 1536) = wv;
    }
}
__device__ __forceinline__ void final_norm(KP P, int c, int G) {
    const int tid = opq_v(threadIdx.x), lane = tid & 63, wave = tid >> 6; unsigned char* ws = P->ws;
    const float* ss2 = (const float*)(ws + WS_CTL + CTL_SS) + 2 * (size_t)T;
    f32x4 g[4];
#pragma unroll
    for (int j = 0; j < 4; ++j) g[j] = ((const f32x4*)P->final_g)[lane + 64 * j];
    for (int row = c * NWAVES + wave; row < T; row += G * NWAVES) {
        const float rs = rsqrtf(ss2[row] * (1.f / D) + EPS);
        f32x4* xr = (f32x4*)(P->out + (size_t)row * D) + lane;
#pragma unroll
        for (int j = 0; j < 4; ++j) { f32x4 v = xr[64 * j]; xr[64 * j] = v * rs * g[j]; }
    }
}

__global__ void __launch_bounds__(NTHREADS, 2) mega_fwd(Args Pv) {
    extern __shared__ __attribute__((aligned(16))) unsigned char lds_raw[];
    LAS unsigned char* lds = (LAS unsigned char*)lds_raw;
    volatile LAS unsigned* MISC = (volatile LAS unsigned*)(lds + MISC_OFF);
    const int tid = threadIdx.x, lane = tid & 63, wave = __builtin_amdgcn_readfirstlane(tid >> 6);
    const int Gb = gridDim.x, cb = blockIdx.x;
    if (tid < 64) MISC[tid] = 0u;
    __syncthreads();
    XcdBarrier bar = xcd_barrier_post((unsigned*)(Pv.ws + WS_CTL + CTL_BAR), MISC + 8);
    const int lo = Pv.ph_lo, hi = Pv.ph_hi;
    for (int ph = lo; ph < hi; ++ph) {
#ifdef REP_KIND
        const int nrep = ((ph == 0 && REP_KIND == 4) || (ph >= 1 && ph <= 8 && ((ph - 1) & 3) == REP_KIND)) ? 2 : 1;
#else
        const int nrep = 1;
#endif
        for (int rep = 0; rep < nrep; ++rep) {
        const int G = opq_s(Gb), c = opq_s(cb);
        if (ph == 0) p0_prologue(kargs(), lds, c, G);
        else {
            const int l = (ph - 1) >> 2, k = (ph - 1) & 3;
            if (k == 1) {
                const int first = ((c >> 3) & 1) ? 1 : 0;
                for (int step = 0; step < 2; ++step) {
                    if ((step ^ first) == 0) { if (c < 256) fft_load_tables(kargs(), lds); for (int u = c; u < 256; u += G) fft_unit(kargs(), u, lds); }
                    else { for (int u = c; u < T / 64; u += G) { const int ub = (u & 7) * 32 + (u >> 3);
                               conv_unit(kargs(), l, ub, lds); short_chunk(kargs(), l, ub * NWAVES + wave, lane); } }
                }
                if (l + 1 < DEPTH) p0_weights(kargs(), lds, c, G, l + 1);
            } else {
                const bool split = (k == 2) && (G == 256) && (MISC[11] == 1u);
                Sched sc{k, l, G, c, split ? (unsigned*)(kargs()->ws + WS_CTL + CTL_GBAR) + 4096 * (c & 7) : nullptr}; gemm_phase(lds, sc, kargs()); }
        }
        if (ph + 1 < hi || rep + 1 < nrep) {
            unsigned* gbar = (unsigned*)(kargs()->ws + WS_CTL + CTL_GBAR) + 4096 * (c & 7);
            unsigned* prep = (unsigned*)(kargs()->ws + WS_CTL + CTL_PREP);
            const bool grp = (G == 256) && ph > 0;
            if (!grp) {
                xcd_barrier(bar);
                if (ph == 0 && G == 256 && tid == 0) (void)xb_add(&gbar[XB_XCNT(bar.x)], 1u);
            } else {
                XcdBarrier gb; gb.bar = gbar; gb.x = bar.x; gb.st = MISC + 10; gb.G = 32u;
                if (((ph - 1) & 3) == 1 && MISC[11] == 1u) {
                    asm volatile("s_waitcnt vmcnt(0)" ::: "memory");
                    __syncthreads();
                    if (tid == 0) (void)xb_add(&gbar[XB_ARR((ph - 1) >> 2)], 1u);
                } else xcd_barrier(gb, true);
                if (ph == 2 && tid == 0) (void)xb_add(prep, 1u);
                if (ph == 4) {
                    if (tid == 0) { XB_SPIN(xb_ld(prep) < 256u, gbar); __builtin_amdgcn_fence(__ATOMIC_ACQUIRE, "agent"); }
                    __syncthreads();
                }
            }
        }
        }
    }
}
}

extern "C" void kernel_launch(void* const* d_in, const int* in_sizes, int n_in, void* d_out, int out_size, void* d_ws, size_t ws_size, hipStream_t stream) {
    static int grid = 0;
    if (grid == 0) {
        int dev = 0, cus = 0, per_cu = 0;
        if (n_in != 13 || out_size != T * D || ws_size < WS_END) { fprintf(stderr, "kernel_launch: unexpected problem shape (n_in %d, out %d, ws %zu)\n", n_in, out_size, ws_size); grid = -1; return; }
        if (hipGetDevice(&dev) != hipSuccess || hipDeviceGetAttribute(&cus, hipDeviceAttributeMultiprocessorCount, dev) != hipSuccess) { grid = -1; return; }
        if (hipFuncSetAttribute((const void*)mega_fwd, hipFuncAttributeMaxDynamicSharedMemorySize, LDS_BYTES) != hipSuccess) { fprintf(stderr, "kernel_launch: hipFuncSetAttribute failed\n"); grid = -1; return; }
        if (hipOccupancyMaxActiveBlocksPerMultiprocessor(&per_cu, (const void*)mega_fwd, NTHREADS, LDS_BYTES) != hipSuccess || per_cu < 1) { fprintf(stderr, "kernel_launch: occupancy query says %d blocks per CU\n", per_cu); per_cu = 1; }
        (void)hipGetLastError();
        grid = cus;
        if (grid > 256) grid = 256;
        grid &= ~7;
    }
    if (grid <= 0) return;
    (void)hipMemsetAsync((char*)d_ws + WS_CTL + CTL_BAR, 0, XCD_BAR_WORDS * 4, stream);
    Args a{};
    a.x = (const float*)d_in[0]; a.norm_g = (const float*)d_in[1]; a.w_in = (const float*)d_in[2]; a.b_in = (const float*)d_in[3]; a.conv_c_w = (const float*)d_in[4]; a.conv_c_b = (const float*)d_in[5];
    a.ln_c_g = (const float*)d_in[6]; a.ln_c_b = (const float*)d_in[7]; a.conv_s_w = (const float*)d_in[8]; a.conv_s_b = (const float*)d_in[9]; a.w_branch = (const float*)d_in[10]; a.w_out = (const float*)d_in[11];
    a.final_g = (const float*)d_in[12]; a.out = (float*)d_out; a.ws = (unsigned char*)d_ws;
#if MK_N_LAUNCHES == 1
    a.ph_lo = 0; a.ph_hi = 9;
    hipLaunchKernelGGL(mega_fwd, dim3(grid), dim3(NTHREADS), LDS_BYTES, stream, a);
#else
    for (int p = 0; p < 9; ++p) { a.ph_lo = p; a.ph_hi = p + 1; hipLaunchKernelGGL(mega_fwd, dim3(grid), dim3(NTHREADS), LDS_BYTES, stream, a); }
#endif
}
```
